# Optimizing an MI355X kernel written in HIP

```python
import jax, jax.numpy as jnp
from jax import lax
import numpy as np

D_MODEL = 1024
BATCH = 8
SEQ = 4096
DEPTH = 1

CHUNK = 64
D_MIX = D_MODEL
SWA_HEAD_DIM = 64
SWA_HEADS = (D_MIX // 2) // SWA_HEAD_DIM
SWA_KV_HEADS = 2
SWA_WIDTH = SWA_HEADS * SWA_HEAD_DIM
SWA_KV_WIDTH = SWA_KV_HEADS * SWA_HEAD_DIM
WINDOW = 128
WINDOW_CHUNKS = WINDOW // CHUNK
HGRN_HEAD_DIM = 128
HGRN_WIDTH = D_MIX - SWA_WIDTH
HGRN_HEADS = HGRN_WIDTH // HGRN_HEAD_DIM
IN_SIZES = (SWA_WIDTH, SWA_KV_WIDTH, SWA_KV_WIDTH,
            HGRN_WIDTH, HGRN_WIDTH, HGRN_WIDTH, HGRN_WIDTH)
D_IN = sum(IN_SIZES)
IN_SPLITS = [int(v) for v in np.cumsum(IN_SIZES)[:-1]]
MEM_LEN = 256
XATTN_HEADS = 4
XATTN_HEAD_DIM = D_MODEL // XATTN_HEADS
D_FF = ((8 * D_MODEL // 3 + 255) // 256) * 256
RMS_EPS = 1e-6
NEG_INF = -1e30

kernel_name = "hymba_swa_sink_hgrn2_xattn_layer"


def rms_norm(x, g):
    xf = x.astype(jnp.float32)
    y = xf * lax.rsqrt(jnp.mean(xf * xf, axis=-1, keepdims=True) + RMS_EPS)
    return (y * g.astype(jnp.float32)).astype(x.dtype)


def swa_with_sinks(q, k, v, sinks):
    B, T, Hq, Dh = q.shape
    Hkv = k.shape[2]
    G = Hq // Hkv
    NC = T // CHUNK
    WC = WINDOW_CHUNKS
    L = (WC + 1) * CHUNK
    qc = q.reshape(B, NC, CHUNK, Hkv, G, Dh)
    pad = ((0, 0), (WC * CHUNK, 0), (0, 0), (0, 0))
    kc = jnp.pad(k, pad).reshape(B, NC + WC, CHUNK, Hkv, Dh)
    vc = jnp.pad(v, pad).reshape(B, NC + WC, CHUNK, Hkv, Dh)
    kband = jnp.concatenate([kc[:, j:j + NC] for j in range(WC + 1)], axis=2)
    vband = jnp.concatenate([vc[:, j:j + NC] for j in range(WC + 1)], axis=2)
    band_chunk = jnp.arange(NC)[:, None] - WC + jnp.arange(WC + 1)[None, :]
    valid = jnp.repeat(band_chunk >= 0, CHUNK, axis=1)
    s = jnp.einsum('bnqhgd,bnkhd->bnhgqk', qc, kband).astype(jnp.float32) * (Dh ** -0.5)
    s = jnp.where(valid[None, :, None, None, None, :], s, NEG_INF)
    sink = jnp.broadcast_to(sinks.astype(jnp.float32).reshape(1, 1, Hkv, G, 1, 1),
                            (B, NC, Hkv, G, CHUNK, 1))
    p = jax.nn.softmax(jnp.concatenate([s, sink], axis=-1), axis=-1)[..., :L]
    o = jnp.einsum('bnhgqk,bnkhd->bnqhgd', p.astype(v.dtype), vband)
    return o.reshape(B, T, Hq * Dh)


def hgrn2(q, f_logit, i, g, lb, onorm_g):
    B, T, H, Dk = q.shape
    Dv = i.shape[-1]
    NC = T // CHUNK
    f32 = jnp.float32
    qf = jax.nn.silu(q.astype(f32)) * (Dk ** -0.5)
    lbf = lb.astype(f32)
    f = lbf + (1.0 - lbf) * jax.nn.sigmoid(f_logit.astype(f32))
    kf = 1.0 - f
    logf = jnp.log(f)

    def chunks(a):
        return a.reshape(B, NC, CHUNK, H, a.shape[-1]).transpose(0, 3, 1, 2, 4)

    qc, kc, vc, lc = chunks(qf), chunks(kf), chunks(i.astype(f32)), chunks(logf)
    b = jnp.cumsum(lc, axis=3)
    b_mid = b[:, :, :, CHUNK // 2 - 1:CHUNK // 2]
    b_last = b[:, :, :, CHUNK - 1:CHUNK]
    A = jnp.einsum('bhnqd,bhnkd->bhnqk', qc * jnp.exp(b - b_mid), kc * jnp.exp(b_mid - b))
    causal = jnp.tril(jnp.ones((CHUNK, CHUNK), dtype=bool))
    A = jnp.where(causal, A, 0.0)
    o_intra = jnp.einsum('bhnqk,bhnkv->bhnqv', A, vc)
    kv = jnp.einsum('bhnkd,bhnkv->bhndv', kc * jnp.exp(b_last - b), vc)
    decay = jnp.exp(b_last[:, :, :, 0, :])

    def step(S, inp):
        d, u = inp
        return d[..., None] * S + u, S

    S0 = jnp.zeros((B, H, Dk, Dv), f32)
    _, S_prev = lax.scan(step, S0, (jnp.moveaxis(decay, 2, 0), jnp.moveaxis(kv, 2, 0)))
    S_prev = jnp.moveaxis(S_prev, 0, 2)
    o_inter = jnp.einsum('bhnqd,bhndv->bhnqv', qc * jnp.exp(b), S_prev)
    o = (o_intra + o_inter).transpose(0, 2, 3, 1, 4).reshape(B, T, H, Dv)
    o = rms_norm(o, onorm_g) * jax.nn.silu(g.astype(f32))
    return o.reshape(B, T, H * Dv).astype(q.dtype)


def cross_attention(u, m, wq, wk, wv, wo):
    B, T, _ = u.shape
    M = m.shape[1]
    q = (u @ wq).reshape(B, T, XATTN_HEADS, XATTN_HEAD_DIM)
    k = (m @ wk).reshape(B, M, XATTN_HEADS, XATTN_HEAD_DIM)
    v = (m @ wv).reshape(B, M, XATTN_HEADS, XATTN_HEAD_DIM)
    s = jnp.einsum('bthd,bmhd->bhtm', q, k).astype(jnp.float32) * (XATTN_HEAD_DIM ** -0.5)
    p = jax.nn.softmax(s, axis=-1).astype(v.dtype)
    o = jnp.einsum('bhtm,bmhd->bthd', p, v).reshape(B, T, D_MODEL)
    return o @ wo


def setup_inputs(seed: int = 0) -> dict:
    key = jax.random.key(seed)
    ks = jax.random.split(key, 24)
    f32 = jnp.float32

    def nrm(k, shape, scale):
        return jax.random.normal(k, shape, f32) * scale

    def gain(k, shape):
        return 1.0 + 0.05 * jax.random.normal(k, shape, f32)

    return {
        "x": nrm(ks[0], (BATCH, SEQ, D_MODEL), 1.0),
        "mem": nrm(ks[1], (BATCH, MEM_LEN, D_MODEL), 1.0),
        "w_in": nrm(ks[2], (DEPTH, D_MODEL, D_IN), D_MODEL ** -0.5),
        "sinks": nrm(ks[3], (DEPTH, SWA_HEADS), 0.5),
        "hgrn_lb": nrm(ks[4], (DEPTH + 1, HGRN_WIDTH), 0.1),
        "hgrn_onorm": gain(ks[5], (DEPTH, HGRN_HEAD_DIM)),
        "w_out": nrm(ks[6], (DEPTH, D_MIX, D_MODEL), D_MIX ** -0.5),
        "g_mix_pre": gain(ks[7], (DEPTH, D_MODEL)),
        "g_mix_post": gain(ks[8], (DEPTH, D_MODEL)),
        "g_mem": gain(ks[9], (DEPTH, D_MODEL)),
        "g_x_pre": gain(ks[10], (DEPTH, D_MODEL)),
        "g_x_post": gain(ks[11], (DEPTH, D_MODEL)),
        "wq_x": nrm(ks[12], (DEPTH, D_MODEL, D_MODEL), D_MODEL ** -0.5),
        "wk_x": nrm(ks[13], (DEPTH, D_MODEL, D_MODEL), D_MODEL ** -0.5),
        "wv_x": nrm(ks[14], (DEPTH, D_MODEL, D_MODEL), D_MODEL ** -0.5),
        "wo_x": nrm(ks[15], (DEPTH, D_MODEL, D_MODEL), D_MODEL ** -0.5),
        "g_ffn_pre": gain(ks[16], (DEPTH, D_MODEL)),
        "g_ffn_post": gain(ks[17], (DEPTH, D_MODEL)),
        "w_gate": nrm(ks[18], (DEPTH, D_MODEL, D_FF), D_MODEL ** -0.5),
        "w_up": nrm(ks[19], (DEPTH, D_MODEL, D_FF), D_MODEL ** -0.5),
        "w_down": nrm(ks[20], (DEPTH, D_FF, D_MODEL), D_FF ** -0.5),
    }


def reference(x, mem, w_in, sinks, hgrn_lb, hgrn_onorm, w_out, g_mix_pre, g_mix_post,
              g_mem, g_x_pre, g_x_post, wq_x, wk_x, wv_x, wo_x, g_ffn_pre, g_ffn_post,
              w_gate, w_up, w_down):
    B, T, _ = x.shape
    lb_all = jnp.cumsum(jax.nn.softmax(hgrn_lb.astype(jnp.float32), axis=0), axis=0)
    h = x
    for l in range(DEPTH):
        u = rms_norm(h, g_mix_pre[l])
        z = u @ w_in[l]
        qa, ka, va, qh, fh, ih, gh = jnp.split(z, IN_SPLITS, axis=-1)
        ya = swa_with_sinks(qa.reshape(B, T, SWA_HEADS, SWA_HEAD_DIM),
                            ka.reshape(B, T, SWA_KV_HEADS, SWA_HEAD_DIM),
                            va.reshape(B, T, SWA_KV_HEADS, SWA_HEAD_DIM),
                            sinks[l])
        hv = HGRN_WIDTH // HGRN_HEADS
        yh = hgrn2(qh.reshape(B, T, HGRN_HEADS, HGRN_HEAD_DIM),
                   fh.reshape(B, T, HGRN_HEADS, HGRN_HEAD_DIM),
                   ih.reshape(B, T, HGRN_HEADS, hv),
                   gh.reshape(B, T, HGRN_HEADS, hv),
                   lb_all[l].reshape(HGRN_HEADS, HGRN_HEAD_DIM),
                   hgrn_onorm[l])
        y = jnp.concatenate([ya, yh.astype(ya.dtype)], axis=-1) @ w_out[l]
        h = h + rms_norm(y, g_mix_post[l])
        u = rms_norm(h, g_x_pre[l])
        m = rms_norm(mem, g_mem[l])
        y = cross_attention(u, m, wq_x[l], wk_x[l], wv_x[l], wo_x[l])
        h = h + rms_norm(y, g_x_post[l])
        u = rms_norm(h, g_ffn_pre[l])
        y = (jax.nn.silu(u @ w_gate[l]) * (u @ w_up[l])) @ w_down[l]
        h = h + rms_norm(y, g_ffn_post[l])
    return h
```

```cpp
#include <hip/hip_runtime.h>
#include <hip/hip_cooperative_groups.h>
#include <cstdio>
#include <cstdint>
namespace cg = cooperative_groups;

#define LAS __attribute__((address_space(3)))
#define GAS __attribute__((address_space(1)))
typedef unsigned short bf16_t;
typedef short bf16x8 __attribute__((ext_vector_type(8)));
typedef short s16x4 __attribute__((ext_vector_type(4)));
typedef float f32x2 __attribute__((ext_vector_type(2)));
typedef float f32x4 __attribute__((ext_vector_type(4)));
typedef float f32x16 __attribute__((ext_vector_type(16)));
typedef unsigned u32x2 __attribute__((ext_vector_type(2)));
typedef unsigned u32x4 __attribute__((ext_vector_type(4)));
typedef __bf16 bf16x2_t __attribute__((ext_vector_type(2)));

#ifndef MK_PER_PHASE
#define MK_PER_PHASE 0
#endif

constexpr int BATCH = 8, T = 4096, D = 1024, M = BATCH * T;
constexpr int DIN = 2816, DFF = 2816, MEM = 256, MROWS = BATCH * MEM;
constexpr int ZQA = 0, ZKA = 512, ZVA = 640, ZQB = 768, ZFB = 1280, ZIB = 1792, ZGB = 2304;
constexpr float RMS_EPS = 1e-6f;
constexpr int NWAVES = 8, NTHREADS = 512;

constexpr size_t MiB = 1u << 20;
constexpr size_t WS_WIN = 2 * MiB;
constexpr size_t WS_WOUT = 8 * MiB;
constexpr size_t WS_WQB = 10 * MiB;
constexpr size_t WS_WKV = 12 * MiB;
constexpr size_t WS_WOT = 16 * MiB;
constexpr size_t WS_WGU = 18 * MiB;
constexpr size_t WS_WD = 30 * MiB;
constexpr size_t WS_MN = 36 * MiB;
constexpr size_t WS_KV = 40 * MiB;
constexpr size_t WS_MC = 48 * MiB;
constexpr size_t WS_VW = 64 * MiB;
constexpr size_t WS_U = 96 * MiB;
constexpr size_t WS_P = 160 * MiB;
constexpr size_t WS_Z = 224 * MiB;
constexpr size_t WS_END = 400 * MiB;
constexpr size_t WS_Y12 = WS_Z;
constexpr size_t WS_Y3 = WS_U;

constexpr int RING_BYTES = 131072;
constexpr int XS_OFF = RING_BYTES;
constexpr int LDS_BYTES = 147456;

__device__ __forceinline__ unsigned pk2(float lo, float hi) { f32x2 v = {lo, hi}; bf16x2_t b = __builtin_convertvector(v, bf16x2_t); return __builtin_bit_cast(unsigned, b); }
__device__ __forceinline__ float bf_lo(unsigned u) { return __uint_as_float(u << 16); }
__device__ __forceinline__ float bf_hi(unsigned u) { return __uint_as_float(u & 0xffff0000u); }
__device__ __forceinline__ float wave_sum(float v) {
#pragma unroll
    for (int o = 1; o < 64; o <<= 1) v += __shfl_xor(v, o);
    return v;
}
__device__ __forceinline__ float fast_exp2(float x) { return __builtin_amdgcn_exp2f(x); }
__device__ __forceinline__ float fast_rcp(float x) { return __builtin_amdgcn_rcpf(x); }
__device__ __forceinline__ float sigmoidf_(float x) { return fast_rcp(1.0f + fast_exp2(-1.4426950408889634f * x)); }
#define LDS_WAIT() asm volatile("s_waitcnt lgkmcnt(0)" ::: "memory")
#define MFMA32(a, b, c) __builtin_amdgcn_mfma_f32_32x32x16_bf16((a), (b), (c), 0, 0, 0)

namespace pg8 {
constexpr int BM = 256, BK = 64, HALF = 128, HTB = HALF * BK * 2, NXCD = 8, WGM = 8;
__host__ __device__ __forceinline__ int lds_byte(int r, int c) { const int st = (r >> 4) * 2 + (c >> 5), rr = r & 15, cc = c & 31, ob = rr * 64 + cc * 2; return st * 1024 + (ob ^ (((ob >> 9) & 1) << 5)); }
__host__ __device__ __forceinline__ void stage_rc(int b, int& R, int& C) { const int st = b / 1024, sb = b % 1024, swz = sb ^ (((sb >> 9) & 1) << 5); R = (st >> 1) * 16 + swz / 64; C = (st & 1) * 32 + (swz % 64) / 2; }
__host__ __device__ __forceinline__ int perm32(int rho) { const int n = rho >> 4, i = rho & 15; return 8 * (i >> 2) + 4 * n + (i & 3); }

struct Unit { int pm, pn, kind; };

__device__ __forceinline__ void tile_of(int L, int nM, int nN, int& pm, int& pn) {
    const int nwg = nM * nN; int wgid = L;
    { const int q = nwg / NXCD, r = nwg % NXCD, xcd = wgid % NXCD, off = wgid / NXCD; wgid = (xcd < r ? xcd * (q + 1) : r * (q + 1) + (xcd - r) * q) + off; }
    const int nig = WGM * nN, gid = wgid / nig, fm = gid * WGM, gsz = (nM - fm) < WGM ? (nM - fm) : WGM;
    pm = fm + ((wgid % nig) % gsz); pn = (wgid % nig) / gsz;
}
struct OrderMN {
    int nM, nN, G, c;
    __device__ __forceinline__ bool next(int i, Unit& u) const { const int L = i * G + c; if (c < 0 || L >= nM * nN) return false; tile_of(L, nM, nN, u.pm, u.pn); u.kind = 0; return true; }
};
struct OrderG1 {
    int G, c;
    __device__ __forceinline__ bool next(int i, Unit& u) const {
        const int L = i * G + c;
        if (L < 128 * 11) { tile_of(L, 128, 11, u.pm, u.pn); u.kind = 0; return true; }
        const int L2 = L - 128 * 11; if (L2 >= 64) return false;
        u.pm = L2 >> 3; u.pn = L2 & 7; u.kind = 1; return true;
    }
};
struct OrderLin {
    int nM, nN, G, c;
    __device__ __forceinline__ bool next(int i, Unit& u) const { const int L = i * G + c; if (c < 0 || L >= nM * nN) return false; u.pm = L / nN; u.pn = L % nN; u.kind = 0; return true; }
};

struct ProbPlain { const bf16_t* A; const bf16_t* Bt; int K, lda, ldb;
    __device__ __forceinline__ const char* a_ptr(const Unit& u) const { return (const char*)(A + (size_t)u.pm * 256 * lda); }
    __device__ __forceinline__ const char* b_ptr(const Unit& u) const { return (const char*)(Bt + (size_t)u.pn * 256 * ldb); } };
struct ProbG1 { const bf16_t* A0; const bf16_t* B0; const bf16_t* A1; const bf16_t* B1; int K, lda, ldb;
    __device__ __forceinline__ const char* a_ptr(const Unit& u) const { return (const char*)((u.kind ? A1 : A0) + (size_t)u.pm * 256 * lda); }
    __device__ __forceinline__ const char* b_ptr(const Unit& u) const { return (const char*)((u.kind ? B1 : B0) + (size_t)u.pn * 256 * ldb); } };
struct ProbBatchB { const bf16_t* A; const bf16_t* Bt; int K, lda, ldb;
    __device__ __forceinline__ const char* a_ptr(const Unit& u) const { return (const char*)(A + (size_t)u.pm * 256 * lda); }
    __device__ __forceinline__ const char* b_ptr(const Unit& u) const { return (const char*)(Bt + (size_t)(u.pm >> 4) * 1024 * 1024 + (size_t)u.pn * 256 * ldb); } };
struct ProbMcat { const bf16_t* KV; const bf16_t* WqB; int K, lda, ldb;
    __device__ __forceinline__ const char* a_ptr(const Unit& u) const { return (const char*)(KV + (size_t)(u.pm >> 2) * 256 * 2048 + (u.pm & 3) * 256); }
    __device__ __forceinline__ const char* b_ptr(const Unit& u) const { return (const char*)(WqB + (size_t)u.pn * 256 * 1024 + (u.pm & 3) * 256); } };
struct ProbVW { const bf16_t* WoT; const bf16_t* KV; int K, lda, ldb;
    __device__ __forceinline__ const char* a_ptr(const Unit& u) const { return (const char*)(WoT + (size_t)(u.pm & 3) * 256 * 1024 + u.pn * 256); }
    __device__ __forceinline__ const char* b_ptr(const Unit& u) const { return (const char*)(KV + (size_t)(u.pm >> 2) * 256 * 2048 + 1024 + u.pn * 256); } };

struct EpiBf16 {
    static constexpr bool PERM = true, NEEDS_BAR = false;
    bf16_t* O0; int ldc0; bf16_t* O1; int ldc1;
    __device__ __forceinline__ void operator()(f32x4 (&acc)[2][2][4][2], const Unit& u, int wr, int wc, int fr, int fq, LAS unsigned char*) const {
        bf16_t* O = u.kind ? O1 : O0; const int ldc = u.kind ? ldc1 : ldc0;
        const int row0 = u.pm * BM + wr * 64 + fr, col0 = u.pn * BM + wc * 32 + 8 * fq;
#pragma unroll
        for (int ai = 0; ai < 2; ++ai)
#pragma unroll
            for (int m = 0; m < 4; ++m) { bf16_t* rowp = O + (size_t)(row0 + ai * HALF + m * 16) * ldc + col0;
#pragma unroll
                for (int bj = 0; bj < 2; ++bj) { const f32x4 v0 = acc[ai][bj][m][0], v1 = acc[ai][bj][m][1];
                    u32x4 w; w.x = pk2(v0[0], v0[1]); w.y = pk2(v0[2], v0[3]); w.z = pk2(v1[0], v1[1]); w.w = pk2(v1[2], v1[3]);
                    *(u32x4*)(rowp + bj * HALF) = w; } }
    }
};
struct EpiF32 {
    static constexpr bool PERM = true, NEEDS_BAR = false;
    float* O; int ldc;
    __device__ __forceinline__ void operator()(f32x4 (&acc)[2][2][4][2], const Unit& u, int wr, int wc, int fr, int fq, LAS unsigned char*) const {
        const int row0 = u.pm * BM + wr * 64 + fr, col0 = u.pn * BM + wc * 32 + 8 * fq;
#pragma unroll
        for (int ai = 0; ai < 2; ++ai)
#pragma unroll
            for (int m = 0; m < 4; ++m) { float* rowp = O + (size_t)(row0 + ai * HALF + m * 16) * ldc + col0;
#pragma unroll
                for (int bj = 0; bj < 2; ++bj) { *(f32x4*)(rowp + bj * HALF) = acc[ai][bj][m][0]; *(f32x4*)(rowp + bj * HALF + 4) = acc[ai][bj][m][1]; } }
    }
};
struct EpiSwiGLU {
    static constexpr bool PERM = true, NEEDS_BAR = false;
    bf16_t* O; int ldc;
    __device__ __forceinline__ void operator()(f32x4 (&acc)[2][2][4][2], const Unit& u, int wr, int wc, int fr, int fq, LAS unsigned char*) const {
        const int row0 = u.pm * BM + wr * 64 + fr, col0 = u.pn * HALF + wc * 32 + 8 * fq;
#pragma unroll
        for (int ai = 0; ai < 2; ++ai)
#pragma unroll
            for (int m = 0; m < 4; ++m) { bf16_t* rowp = O + (size_t)(row0 + ai * HALF + m * 16) * ldc + col0;
                float o[8];
#pragma unroll
                for (int n = 0; n < 2; ++n)
#pragma unroll
                    for (int j = 0; j < 4; ++j) { const float g = acc[ai][0][m][n][j], up = acc[ai][1][m][n][j]; o[n * 4 + j] = g * sigmoidf_(g) * up; }
                u32x4 w; w.x = pk2(o[0], o[1]); w.y = pk2(o[2], o[3]); w.z = pk2(o[4], o[5]); w.w = pk2(o[6], o[7]);
                *(u32x4*)rowp = w; }
    }
};
struct EpiSoftmax {
    static constexpr bool PERM = true, NEEDS_BAR = true;
    bf16_t* O; int ldc;
    __device__ __forceinline__ void operator()(f32x4 (&acc)[2][2][4][2], const Unit& u, int wr, int wc, int fr, int fq, LAS unsigned char* xs) const {
        LAS f32x2* XS = (LAS f32x2*)xs;
        float mw[2][4];
#pragma unroll
        for (int ai = 0; ai < 2; ++ai)
#pragma unroll
            for (int m = 0; m < 4; ++m) {
                float mx = -3.0e38f;
#pragma unroll
                for (int bj = 0; bj < 2; ++bj)
#pragma unroll
                    for (int n = 0; n < 2; ++n) { const f32x4 x = acc[ai][bj][m][n]; mx = fmaxf(mx, fmaxf(fmaxf(x[0], x[1]), fmaxf(x[2], x[3]))); }
                mx = fmaxf(mx, __shfl_xor(mx, 16)); mx = fmaxf(mx, __shfl_xor(mx, 32));
                float s = 0.f;
#pragma unroll
                for (int bj = 0; bj < 2; ++bj)
#pragma unroll
                    for (int n = 0; n < 2; ++n) { f32x4 x = acc[ai][bj][m][n];
#pragma unroll
                        for (int j = 0; j < 4; ++j) { x[j] = fast_exp2((x[j] - mx) * 1.4426950408889634f); s += x[j]; }
                        acc[ai][bj][m][n] = x; }
                s += __shfl_xor(s, 16); s += __shfl_xor(s, 32);
                mw[ai][m] = mx;
                if (fq == 0) XS[(ai * HALF + wr * 64 + m * 16 + fr) * 4 + wc] = (f32x2){mx, s};
            }
        asm volatile("s_waitcnt lgkmcnt(0)" ::: "memory"); __builtin_amdgcn_s_barrier(); asm volatile("" ::: "memory");
        const int row0 = u.pm * BM + wr * 64 + fr, col0 = u.pn * BM + wc * 32 + 8 * fq;
#pragma unroll
        for (int ai = 0; ai < 2; ++ai)
#pragma unroll
            for (int m = 0; m < 4; ++m) {
                const int rl = ai * HALF + wr * 64 + m * 16 + fr;
                const f32x2 a = XS[rl * 4 + 0], b = XS[rl * 4 + 1], c = XS[rl * 4 + 2], d = XS[rl * 4 + 3];
                const float MX = fmaxf(fmaxf(a.x, b.x), fmaxf(c.x, d.x));
                const float L = a.y * fast_exp2((a.x - MX) * 1.4426950408889634f) + b.y * fast_exp2((b.x - MX) * 1.4426950408889634f)
                              + c.y * fast_exp2((c.x - MX) * 1.4426950408889634f) + d.y * fast_exp2((d.x - MX) * 1.4426950408889634f);
                const float f = fast_exp2((mw[ai][m] - MX) * 1.4426950408889634f) / L;
                bf16_t* rowp = O + (size_t)(row0 + ai * HALF + m * 16) * ldc + col0;
#pragma unroll
                for (int bj = 0; bj < 2; ++bj) { const f32x4 v0 = acc[ai][bj][m][0] * f, v1 = acc[ai][bj][m][1] * f;
                    u32x4 w; w.x = pk2(v0[0], v0[1]); w.y = pk2(v0[2], v0[3]); w.z = pk2(v1[0], v1[1]); w.w = pk2(v1[2], v1[3]);
                    *(u32x4*)(rowp + bj * HALF) = w; }
            }
    }
};

template <class Prob, class Epi, class Sched>
__device__ __forceinline__ void gemm_phase(LAS unsigned char* lds, LAS unsigned char* xs, const Prob g, const Sched& S, const Epi& E) {
    const int tid = threadIdx.x, wid = __builtin_amdgcn_readfirstlane(tid >> 6), lane = tid & 63, wr = wid >> 2, wc = wid & 3, fr = lane & 15, fq = lane >> 4;
    const int K = g.K, nt = K / BK;
    unsigned voffA[2], voffB[2];
#pragma unroll
    for (int i = 0; i < 2; ++i) { int R, C; stage_rc(tid * 16 + i * 8192, R, C); const int Rb = Epi::PERM ? ((R & ~31) + perm32(R & 31)) : R;
        voffA[i] = (unsigned)(R * g.lda + C) * 2u; voffB[i] = (unsigned)(Rb * g.ldb + C) * 2u; }
    const size_t kstep = (size_t)(BK * 2);
    const size_t hstepA = (size_t)HALF * g.lda * 2, hstepB = (size_t)HALF * g.ldb * 2;
    const unsigned ldsw = (unsigned)wid * 1024u;
    const int aoff = lds_byte(wr * 64 + fr, fq * 8), boff = lds_byte(wc * 32 + fr, fq * 8);
#define PG8_SA(b, h) (((b) * 2 + (h)) * HTB)
#define PG8_SB(b, h) ((4 + (b) * 2 + (h)) * HTB)
#define PG8_STAGE(bufoff, gbase, voff) do { _Pragma("unroll") for (int _i = 0; _i < 2; ++_i) \
        __builtin_amdgcn_global_load_lds((const unsigned*)((const char*)(gbase) + (voff)[_i]), (LAS unsigned*)(lds + (bufoff) + ldsw + _i * 8192), 16, 0, 0); } while (0)
#define PG8_LDA(dst, b, h) do { _Pragma("unroll") for (int m = 0; m < 4; ++m) _Pragma("unroll") for (int k = 0; k < 2; ++k) dst[m][k] = *(const LAS bf16x8*)(lds + PG8_SA(b, h) + aoff + m * 2048 + k * 1024); } while (0)
#define PG8_LDB(dst, b, h) do { _Pragma("unroll") for (int n = 0; n < 2; ++n) _Pragma("unroll") for (int k = 0; k < 2; ++k) dst[n][k] = *(const LAS bf16x8*)(lds + PG8_SB(b, h) + boff + n * 2048 + k * 1024); } while (0)
#define PG8_MMA(ai, bj, At, Bt) do { __builtin_amdgcn_s_setprio(1); _Pragma("unroll") for (int m = 0; m < 4; ++m) _Pragma("unroll") for (int n = 0; n < 2; ++n) _Pragma("unroll") for (int k = 0; k < 2; ++k) \
        acc[ai][bj][m][n] = __builtin_amdgcn_mfma_f32_16x16x32_bf16(Bt[n][k], At[m][k], acc[ai][bj][m][n], 0, 0, 0); __builtin_amdgcn_s_setprio(0); } while (0)
#define PG8_WAIT_V(n) asm volatile("s_waitcnt vmcnt(" #n ")" ::: "memory")
#define PG8_WAIT_L(n) asm volatile("s_waitcnt lgkmcnt(" #n ")" ::: "memory")
#define PG8_BAR __builtin_amdgcn_s_barrier()
#define PG8_SCHED __builtin_amdgcn_sched_barrier(0)
    Unit cur, nxt; int ui = 0;
    if (!S.next(0, cur)) return;
    f32x4 acc[2][2][4][2];
#pragma unroll
    for (int a = 0; a < 2; ++a)
#pragma unroll
        for (int b = 0; b < 2; ++b)
#pragma unroll
            for (int m = 0; m < 4; ++m)
#pragma unroll
                for (int n = 0; n < 2; ++n) acc[a][b][m][n] = (f32x4){0.f, 0.f, 0.f, 0.f};
    bf16x8 At[4][2], B0[2][2], B1[2][2];
    const char* cA = g.a_ptr(cur); const char* cB = g.b_ptr(cur);
    PG8_STAGE(PG8_SB(0, 0), cB, voffB); PG8_STAGE(PG8_SB(0, 1), cB + hstepB, voffB); PG8_STAGE(PG8_SA(0, 0), cA, voffA); PG8_STAGE(PG8_SA(0, 1), cA + hstepA, voffA);
    if (wr == 1) PG8_BAR;
    PG8_WAIT_V(2); PG8_BAR;
    PG8_STAGE(PG8_SB(1, 0), cB + kstep, voffB); PG8_STAGE(PG8_SA(1, 0), cA + kstep, voffA); PG8_STAGE(PG8_SB(1, 1), cB + hstepB + kstep, voffB);
    PG8_WAIT_V(6); PG8_BAR;
    for (;;) {
        const bool has_next = S.next(ui + 1, nxt);
        const char* nA = has_next ? g.a_ptr(nxt) : cA; const char* nB = has_next ? g.b_ptr(nxt) : cB;
        for (int t = 0; t < nt; t += 2) {
            const bool last = (t == nt - 2);
            const char* a1 = cA + (size_t)(t + 1) * kstep;
            const char* a2 = last ? nA : cA + (size_t)(t + 2) * kstep; const char* b2 = last ? nB : cB + (size_t)(t + 2) * kstep;
            const char* a3 = a2 + kstep; const char* b3 = b2 + kstep;
            PG8_LDB(B0, 0, 0); PG8_LDB(B1, 0, 1); PG8_SCHED; PG8_LDA(At, 0, 0); PG8_STAGE(PG8_SA(1, 1), a1 + hstepA, voffA);
            PG8_WAIT_V(8); PG8_WAIT_L(0); PG8_BAR; PG8_MMA(0, 0, At, B0); PG8_MMA(0, 1, At, B1); PG8_BAR; PG8_SCHED;
            PG8_LDA(At, 0, 1); PG8_STAGE(PG8_SB(0, 0), b2, voffB); PG8_STAGE(PG8_SB(0, 1), b2 + hstepB, voffB); PG8_STAGE(PG8_SA(0, 0), a2, voffA);
            PG8_WAIT_V(8); PG8_WAIT_L(0); PG8_BAR; PG8_MMA(1, 0, At, B0); PG8_MMA(1, 1, At, B1); PG8_BAR; PG8_SCHED;
            PG8_LDB(B0, 1, 0); PG8_LDB(B1, 1, 1); PG8_SCHED; PG8_LDA(At, 1, 0); PG8_STAGE(PG8_SA(0, 1), a2 + hstepA, voffA);
            PG8_WAIT_V(8); PG8_WAIT_L(0); PG8_BAR; PG8_MMA(0, 0, At, B0); PG8_MMA(0, 1, At, B1); PG8_BAR; PG8_SCHED;
            PG8_LDA(At, 1, 1); PG8_STAGE(PG8_SB(1, 0), b3, voffB); PG8_STAGE(PG8_SB(1, 1), b3 + hstepB, voffB); PG8_STAGE(PG8_SA(1, 0), a3, voffA);
            PG8_WAIT_V(8); PG8_WAIT_L(0); PG8_BAR; PG8_MMA(1, 0, At, B0); PG8_MMA(1, 1, At, B1); PG8_BAR; PG8_SCHED;
        }
        if (wr == 0) PG8_BAR;
        E(acc, cur, wr, wc, fr, fq, xs);
        if (!has_next) break;
#pragma unroll
        for (int a = 0; a < 2; ++a)
#pragma unroll
            for (int b = 0; b < 2; ++b)
#pragma unroll
                for (int m = 0; m < 4; ++m)
#pragma unroll
                    for (int n = 0; n < 2; ++n) acc[a][b][m][n] = (f32x4){0.f, 0.f, 0.f, 0.f};
        cur = nxt; cA = nA; cB = nB; ++ui;
        if (wr == 1) PG8_BAR;
    }
    PG8_WAIT_V(0);
    PG8_BAR;
#undef PG8_SA
#undef PG8_SB
#undef PG8_STAGE
#undef PG8_LDA
#undef PG8_LDB
#undef PG8_MMA
#undef PG8_WAIT_V
#undef PG8_WAIT_L
#undef PG8_BAR
#undef PG8_SCHED
}
}

struct Args {
    const float* in[21];
    float* out; unsigned char* ws;
    int ph_lo, ph_hi, k_small, pad;
};
enum { I_X = 0, I_MEM, I_WIN, I_SINKS, I_LB, I_ONORM, I_WOUT, I_GMIXPRE, I_GMIXPOST, I_GMEM, I_GXPRE, I_GXPOST, I_WQ, I_WK, I_WV, I_WO, I_GFFNPRE, I_GFFNPOST, I_WGATE, I_WUP, I_WDOWN };

__device__ __forceinline__ void transpose_item(const float* W, int N, bf16_t* WT, int ldt, int k0, int n0, int dst_row0, float scale, LAS float* scr, int lane) {
#pragma unroll 8
    for (int i = 0; i < 32; ++i) { const int kk = 2 * i + (lane >> 5); scr[kk * 33 + (lane & 31)] = W[(size_t)(k0 + kk) * N + n0 + (lane & 31)] * scale; }
    LDS_WAIT(); asm volatile("" ::: "memory");
    const int c = lane & 7;
#pragma unroll
    for (int j = 0; j < 4; ++j) { const int n = (lane >> 3) + 8 * j; const LAS float* s = scr + (8 * c) * 33 + n;
        u32x4 o; o.x = pk2(s[0 * 33], s[1 * 33]); o.y = pk2(s[2 * 33], s[3 * 33]); o.z = pk2(s[4 * 33], s[5 * 33]); o.w = pk2(s[6 * 33], s[7 * 33]);
        *(u32x4*)(WT + (size_t)(dst_row0 + n) * ldt + k0 + 8 * c) = o; }
    LDS_WAIT(); asm volatile("" ::: "memory");
}
__device__ __forceinline__ void rms_row_to_bf16(const float* xrow, const float* g, bf16_t* orow, int lane) {
    const f32x4* xr = (const f32x4*)xrow + lane; const f32x4* gr = (const f32x4*)g + lane;
    f32x4 v[4]; float s = 0.f;
#pragma unroll
    for (int j = 0; j < 4; ++j) { v[j] = xr[64 * j]; s += (v[j].x * v[j].x + v[j].y * v[j].y) + (v[j].z * v[j].z + v[j].w * v[j].w); }
    const float rstd = 1.0f / sqrtf(wave_sum(s) * (1.f / D) + RMS_EPS);
    u32x2* o8 = (u32x2*)orow + lane;
#pragma unroll
    for (int j = 0; j < 4; ++j) { const f32x4 gg = gr[64 * j]; u32x2 w; w.x = pk2(v[j].x * rstd * gg.x, v[j].y * rstd * gg.y); w.y = pk2(v[j].z * rstd * gg.z, v[j].w * rstd * gg.w); o8[64 * j] = w; }
}
__device__ __forceinline__ void rownorm_pass(const float* y, const float* hin, float* hout, const float* gpost, const float* gpre, bf16_t* uout, int gw, int NGW, int lane) {
    f32x4 gp[4], gq[4];
#pragma unroll
    for (int j = 0; j < 4; ++j) { gp[j] = ((const f32x4*)gpost)[lane + 64 * j]; gq[j] = gpre ? ((const f32x4*)gpre)[lane + 64 * j] : (f32x4){0.f, 0.f, 0.f, 0.f}; }
    for (int m = gw; m < M; m += NGW) {
        const f32x4* yr = (const f32x4*)(y + (size_t)m * D) + lane; const f32x4* hr = (const f32x4*)(hin + (size_t)m * D) + lane;
        f32x4 yv[4], hv[4]; float s = 0.f;
#pragma unroll
        for (int j = 0; j < 4; ++j) { yv[j] = yr[64 * j]; hv[j] = hr[64 * j]; s += (yv[j].x * yv[j].x + yv[j].y * yv[j].y) + (yv[j].z * yv[j].z + yv[j].w * yv[j].w); }
        const float r1 = 1.0f / sqrtf(wave_sum(s) * (1.f / D) + RMS_EPS);
        float s2 = 0.f; f32x4* ho = (f32x4*)(hout + (size_t)m * D) + lane;
#pragma unroll
        for (int j = 0; j < 4; ++j) { hv[j] = hv[j] + yv[j] * r1 * gp[j]; ho[64 * j] = hv[j]; s2 += (hv[j].x * hv[j].x + hv[j].y * hv[j].y) + (hv[j].z * hv[j].z + hv[j].w * hv[j].w); }
        if (uout) {
            const float r2 = 1.0f / sqrtf(wave_sum(s2) * (1.f / D) + RMS_EPS);
            u32x2* o8 = (u32x2*)(uout + (size_t)m * D) + lane;
#pragma unroll
            for (int j = 0; j < 4; ++j) { u32x2 w; w.x = pk2(hv[j].x * r2 * gq[j].x, hv[j].y * r2 * gq[j].y); w.y = pk2(hv[j].z * r2 * gq[j].z, hv[j].w * r2 * gq[j].w); o8[64 * j] = w; }
        }
    }
}

__device__ __forceinline__ void swa_item(LAS unsigned char* lds, const bf16_t* Z, bf16_t* YM, const float* sinks, int item, int tid) {
    const int kvh = item & 1, n = (item >> 1) & 63, b = item >> 7;
    const int wave = tid >> 6, lane = tid & 63, r = lane & 31, h = lane >> 5;
    constexpr int KST = 144, VST = 392;
    LAS unsigned char* Ks = lds;
    LAS unsigned char* Vt = lds + 192 * KST;
    const long tok0 = (long)b * T + (long)(n - 2) * 64;
    for (int id = tid; id < 1536; id += NTHREADS) {
        const int key = id >> 3, c = id & 7; const int ch = n - 2 + (key >> 6);
        u32x4 kq = {0u, 0u, 0u, 0u}, vq = {0u, 0u, 0u, 0u};
        if (ch >= 0) { const bf16_t* row = Z + (size_t)(tok0 + key) * DIN; kq = *(const u32x4*)(row + ZKA + kvh * 64 + c * 8); vq = *(const u32x4*)(row + ZVA + kvh * 64 + c * 8); }
        *(LAS u32x4*)(Ks + key * KST + c * 16) = kq;
#pragma unroll
        for (int i = 0; i < 8; ++i) { const unsigned w = vq[i >> 1]; *(LAS unsigned short*)(Vt + (c * 8 + i) * VST + key * 2) = (unsigned short)((i & 1) ? (w >> 16) : (w & 0xffffu)); }
    }
    const int hq = kvh * 4 + (wave >> 1);
    const size_t tq = (size_t)b * T + n * 64 + (wave & 1) * 32 + r;
    bf16x8 qf[4];
#pragma unroll
    for (int s = 0; s < 4; ++s) qf[s] = *(const bf16x8*)(Z + tq * DIN + ZQA + hq * 64 + 16 * s + 8 * h);
    const float sink = sinks[hq];
    __syncthreads();
    f32x16 st[6];
#pragma unroll
    for (int kt = 0; kt < 6; ++kt) {
#pragma unroll
        for (int i = 0; i < 16; ++i) st[kt][i] = 0.f;
#pragma unroll
        for (int s = 0; s < 4; ++s) { const bf16x8 a = *(const LAS bf16x8*)(Ks + (kt * 32 + r) * KST + (16 * s + 8 * h) * 2); st[kt] = MFMA32(a, qf[s], st[kt]); }
    }
    const bool v0 = n >= 2, v1 = n >= 1;
    float mx = sink;
#pragma unroll
    for (int kt = 0; kt < 6; ++kt) { const bool valid = kt < 2 ? v0 : (kt < 4 ? v1 : true);
        if (valid) {
#pragma unroll
            for (int i = 0; i < 16; ++i) { st[kt][i] *= 0.125f; mx = fmaxf(mx, st[kt][i]); } } }
    mx = fmaxf(mx, __shfl_xor(mx, 32));
    float sum = 0.f;
#pragma unroll
    for (int kt = 0; kt < 6; ++kt) { const bool valid = kt < 2 ? v0 : (kt < 4 ? v1 : true);
#pragma unroll
        for (int i = 0; i < 16; ++i) { const float p = valid ? fast_exp2((st[kt][i] - mx) * 1.4426950408889634f) : 0.f; st[kt][i] = p; sum += p; } }
    sum += __shfl_xor(sum, 32);
    sum += fast_exp2((sink - mx) * 1.4426950408889634f);
    const float inv = 1.0f / sum;
    f32x16 o[2];
#pragma unroll
    for (int dt = 0; dt < 2; ++dt)
#pragma unroll
        for (int i = 0; i < 16; ++i) o[dt][i] = 0.f;
#pragma unroll
    for (int kt = 0; kt < 6; ++kt)
#pragma unroll
        for (int s = 0; s < 2; ++s) {
            u32x4 pw; pw.x = pk2(st[kt][8 * s + 0], st[kt][8 * s + 1]); pw.y = pk2(st[kt][8 * s + 2], st[kt][8 * s + 3]); pw.z = pk2(st[kt][8 * s + 4], st[kt][8 * s + 5]); pw.w = pk2(st[kt][8 * s + 6], st[kt][8 * s + 7]);
            const bf16x8 pb = __builtin_bit_cast(bf16x8, pw);
#pragma unroll
            for (int dt = 0; dt < 2; ++dt) {
                const LAS unsigned char* vp = Vt + (dt * 32 + r) * VST + (kt * 32 + 16 * s + 4 * h) * 2;
                u32x4 aw; const u32x2 a0 = *(const LAS u32x2*)vp, a1 = *(const LAS u32x2*)(vp + 16); aw.x = a0.x; aw.y = a0.y; aw.z = a1.x; aw.w = a1.y;
                o[dt] = MFMA32(__builtin_bit_cast(bf16x8, aw), pb, o[dt]);
            }
        }
    bf16_t* orow = YM + tq * D + hq * 64;
#pragma unroll
    for (int dt = 0; dt < 2; ++dt)
#pragma unroll
        for (int g = 0; g < 4; ++g) { u32x2 w; w.x = pk2(o[dt][4 * g] * inv, o[dt][4 * g + 1] * inv); w.y = pk2(o[dt][4 * g + 2] * inv, o[dt][4 * g + 3] * inv);
            *(u32x2*)(orow + 32 * dt + 8 * g + 4 * h) = w; }
    __syncthreads();
}

constexpr int HG_QD = 0, HG_KD = 17408, HG_QB = 34816, HG_KLT = 52224, HG_IT = 70656, HG_AM = 89088, HG_OB1 = 98304, HG_PART = 132096, HG_DEC = 136192;
constexpr int HG_OB0 = 0;
constexpr int RS = 272, TS = 144, OS = 528;
static_assert(HG_DEC + 512 <= LDS_BYTES, "hgrn lds");
__device__ __forceinline__ void hgrn_seq(LAS unsigned char* lds, const bf16_t* Z, bf16_t* YM, const float* lbp, const float* onorm, int bh, int tid) {
    const int b = bh >> 2, hh = bh & 3;
    const int wave = tid >> 6, lane = tid & 63, r = lane & 31, h = lane >> 5;
    const int cp = tid & 63, rg = tid >> 6;
    float lbv[2];
#pragma unroll
    for (int e = 0; e < 2; ++e) { const float a0 = lbp[hh * 128 + 2 * cp + e], a1 = lbp[512 + hh * 128 + 2 * cp + e]; lbv[e] = 1.0f / (1.0f + __expf(a1 - a0)); }
    const int vt = wave & 3, dh = wave >> 2;
    f32x16 S[2];
#pragma unroll
    for (int i = 0; i < 16; ++i) { S[0][i] = 0.f; S[1][i] = 0.f; }
    const int nt_ = tid >> 3, nseg = tid & 7;
    f32x4 og[4];
#pragma unroll
    for (int j = 0; j < 4; ++j) og[j] = *(const f32x4*)(onorm + nseg * 16 + 4 * j);
    LAS float* PART = (LAS float*)(lds + HG_PART);
    LAS float* DEC = (LAS float*)(lds + HG_DEC);
    for (int c = 0; c < 64; ++c) {
        const size_t tokc = (size_t)b * T + (size_t)c * 64;
        unsigned qv[8], fv[8], iv[8];
#pragma unroll
        for (int i = 0; i < 8; ++i) { const bf16_t* row = Z + (tokc + rg * 8 + i) * DIN + hh * 128 + 2 * cp;
            qv[i] = *(const unsigned*)(row + ZQB); fv[i] = *(const unsigned*)(row + ZFB); iv[i] = *(const unsigned*)(row + ZIB); }
        float cs[2][8], kk[2][8];
#pragma unroll
        for (int e = 0; e < 2; ++e) { float run = 0.f;
#pragma unroll
            for (int i = 0; i < 8; ++i) { const float fl = e ? bf_hi(fv[i]) : bf_lo(fv[i]); const float f = lbv[e] + (1.0f - lbv[e]) * sigmoidf_(fl);
                run += __builtin_amdgcn_logf(f); cs[e][i] = run; kk[e][i] = 1.0f - f; }
            PART[rg * 128 + 2 * cp + e] = run; }
        __syncthreads();
        {
            u32x4 itw[2];
#pragma unroll
            for (int e = 0; e < 2; ++e) {
                itw[e].x = e ? ((iv[0] >> 16) | (iv[1] & 0xffff0000u)) : ((iv[0] & 0xffffu) | (iv[1] << 16));
                itw[e].y = e ? ((iv[2] >> 16) | (iv[3] & 0xffff0000u)) : ((iv[2] & 0xffffu) | (iv[3] << 16));
                itw[e].z = e ? ((iv[4] >> 16) | (iv[5] & 0xffff0000u)) : ((iv[4] & 0xffffu) | (iv[5] << 16));
                itw[e].w = e ? ((iv[6] >> 16) | (iv[7] & 0xffff0000u)) : ((iv[6] & 0xffffu) | (iv[7] << 16));
                *(LAS u32x4*)(lds + HG_IT + (2 * cp + e) * TS + rg * 16) = itw[e];
            }
            float qd[2][8], qb[2][8], kd[2][8], kl[2][8];
#pragma unroll
            for (int e = 0; e < 2; ++e) { const int d = 2 * cp + e;
                float offs = 0.f, bmid = 0.f, blast = 0.f;
#pragma unroll
                for (int q = 0; q < 8; ++q) { const float p = PART[q * 128 + d]; offs += (q < rg) ? p : 0.f; bmid += (q < 4) ? p : 0.f; blast += p; }
                const float cM = fast_exp2(bmid), cL = fast_exp2(blast - bmid);
                if (rg == 0) DEC[d] = fast_exp2(blast);
#pragma unroll
                for (int i = 0; i < 8; ++i) { const float bb = offs + cs[e][i]; const float e1 = fast_exp2(bb - bmid), e2 = fast_exp2(bmid - bb);
                    const float q = e ? bf_hi(qv[i]) : bf_lo(qv[i]); const float sq = q * sigmoidf_(q) * 0.08838834764831845f;
                    qd[e][i] = sq * e1; qb[e][i] = qd[e][i] * cM; kd[e][i] = kk[e][i] * e2; kl[e][i] = kd[e][i] * cL; }
                u32x4 w; w.x = pk2(kl[e][0], kl[e][1]); w.y = pk2(kl[e][2], kl[e][3]); w.z = pk2(kl[e][4], kl[e][5]); w.w = pk2(kl[e][6], kl[e][7]);
                *(LAS u32x4*)(lds + HG_KLT + d * TS + rg * 16) = w;
            }
#pragma unroll
            for (int i = 0; i < 8; ++i) { const int t = rg * 8 + i;
                *(LAS unsigned*)(lds + HG_QD + t * RS + cp * 4) = pk2(qd[0][i], qd[1][i]);
                *(LAS unsigned*)(lds + HG_QB + t * RS + cp * 4) = pk2(qb[0][i], qb[1][i]);
                *(LAS unsigned*)(lds + HG_KD + t * RS + cp * 4) = pk2(kd[0][i], kd[1][i]); }
        }
        __syncthreads();
        if (wave < 4) {
            const int tt = (wave == 0) ? 0 : 1, ttp = (wave == 2) ? 1 : 0;
            f32x16 a;
#pragma unroll
            for (int i = 0; i < 16; ++i) a[i] = 0.f;
            const int tq_ = (wave == 3) ? 0 : tt, tp_ = (wave == 3) ? 1 : ttp;
            if (wave < 3) {
#pragma unroll
                for (int s = 0; s < 8; ++s) {
                    const bf16x8 ka = *(const LAS bf16x8*)(lds + HG_KD + (32 * tp_ + r) * RS + (16 * s + 8 * h) * 2);
                    const bf16x8 qb_ = *(const LAS bf16x8*)(lds + HG_QD + (32 * tq_ + r) * RS + (16 * s + 8 * h) * 2);
                    a = MFMA32(ka, qb_, a);
                }
            }
            const int t = 32 * tq_ + r;
#pragma unroll
            for (int g = 0; g < 4; ++g) { float x[4];
#pragma unroll
                for (int j = 0; j < 4; ++j) { const int tp = 32 * tp_ + 8 * g + 4 * h + j; x[j] = (tp <= t) ? a[4 * g + j] : 0.f; }
                u32x2 w; w.x = pk2(x[0], x[1]); w.y = pk2(x[2], x[3]);
                *(LAS u32x2*)(lds + HG_AM + t * TS + (32 * tp_ + 8 * g + 4 * h) * 2) = w; }
        }
        __syncthreads();
        {
            f32x16 o[2];
#pragma unroll
            for (int tt = 0; tt < 2; ++tt) {
#pragma unroll
                for (int i = 0; i < 16; ++i) o[tt][i] = 0.f;
#pragma unroll
                for (int s = 0; s < 2; ++s) {
                    const bf16x8 aa = *(const LAS bf16x8*)(lds + HG_AM + (32 * tt + r) * TS + (32 * dh + 16 * s + 8 * h) * 2);
                    const bf16x8 ib = *(const LAS bf16x8*)(lds + HG_IT + (32 * vt + r) * TS + (32 * dh + 16 * s + 8 * h) * 2);
                    o[tt] = MFMA32(aa, ib, o[tt]);
                }
            }
#pragma unroll
            for (int dt = 0; dt < 2; ++dt)
#pragma unroll
                for (int s = 0; s < 2; ++s) {
                    u32x4 sw; sw.x = pk2(S[dt][8 * s + 0], S[dt][8 * s + 1]); sw.y = pk2(S[dt][8 * s + 2], S[dt][8 * s + 3]); sw.z = pk2(S[dt][8 * s + 4], S[dt][8 * s + 5]); sw.w = pk2(S[dt][8 * s + 6], S[dt][8 * s + 7]);
                    const bf16x8 sb = __builtin_bit_cast(bf16x8, sw);
#pragma unroll
                    for (int tt = 0; tt < 2; ++tt) {
                        const LAS unsigned char* qp = lds + HG_QB + (32 * tt + r) * RS + (64 * dh + 32 * dt + 16 * s + 4 * h) * 2;
                        u32x4 aw; const u32x2 a0 = *(const LAS u32x2*)qp, a1 = *(const LAS u32x2*)(qp + 16); aw.x = a0.x; aw.y = a0.y; aw.z = a1.x; aw.w = a1.y;
                        o[tt] = MFMA32(__builtin_bit_cast(bf16x8, aw), sb, o[tt]);
                    }
                }
#pragma unroll
            for (int dt = 0; dt < 2; ++dt) {
#pragma unroll
                for (int i = 0; i < 16; ++i) S[dt][i] *= DEC[64 * dh + 32 * dt + (i & 3) + 8 * (i >> 2) + 4 * h];
#pragma unroll
                for (int s = 0; s < 4; ++s) {
                    const bf16x8 ka = *(const LAS bf16x8*)(lds + HG_KLT + (64 * dh + 32 * dt + r) * TS + (16 * s + 8 * h) * 2);
                    const bf16x8 ib = *(const LAS bf16x8*)(lds + HG_IT + (32 * vt + r) * TS + (16 * s + 8 * h) * 2);
                    S[dt] = MFMA32(ka, ib, S[dt]);
                }
            }
            LAS unsigned char* ob = lds + (dh ? HG_OB1 : HG_OB0);
#pragma unroll
            for (int tt = 0; tt < 2; ++tt)
#pragma unroll
                for (int i = 0; i < 16; ++i) *(LAS float*)(ob + (32 * tt + (i & 3) + 8 * (i >> 2) + 4 * h) * OS + (32 * vt + r) * 4) = o[tt][i];
        }
        __syncthreads();
        {
            f32x4 ov[4]; float ss = 0.f;
#pragma unroll
            for (int j = 0; j < 4; ++j) { const f32x4 a = *(const LAS f32x4*)(lds + HG_OB0 + nt_ * OS + (nseg * 16 + 4 * j) * 4), bq = *(const LAS f32x4*)(lds + HG_OB1 + nt_ * OS + (nseg * 16 + 4 * j) * 4);
                ov[j] = a + bq; ss += (ov[j].x * ov[j].x + ov[j].y * ov[j].y) + (ov[j].z * ov[j].z + ov[j].w * ov[j].w); }
            ss += __shfl_xor(ss, 1); ss += __shfl_xor(ss, 2); ss += __shfl_xor(ss, 4);
            const float rstd = 1.0f / sqrtf(ss * (1.f / 128.f) + RMS_EPS);
            const bf16_t* grow = Z + (tokc + nt_) * DIN + ZGB + hh * 128 + nseg * 16;
            const u32x4 g0 = *(const u32x4*)grow, g1 = *(const u32x4*)(grow + 8);
            float gf[16];
#pragma unroll
            for (int j = 0; j < 4; ++j) { gf[2 * j] = bf_lo(g0[j]); gf[2 * j + 1] = bf_hi(g0[j]); gf[8 + 2 * j] = bf_lo(g1[j]); gf[8 + 2 * j + 1] = bf_hi(g1[j]); }
            float y[16];
#pragma unroll
            for (int j = 0; j < 4; ++j)
#pragma unroll
                for (int q = 0; q < 4; ++q) { const float g = gf[4 * j + q]; y[4 * j + q] = ov[j][q] * rstd * og[j][q] * (g * sigmoidf_(g)); }
            u32x4 w0, w1;
            w0.x = pk2(y[0], y[1]); w0.y = pk2(y[2], y[3]); w0.z = pk2(y[4], y[5]); w0.w = pk2(y[6], y[7]);
            w1.x = pk2(y[8], y[9]); w1.y = pk2(y[10], y[11]); w1.z = pk2(y[12], y[13]); w1.w = pk2(y[14], y[15]);
            bf16_t* orow = YM + (tokc + nt_) * D + 512 + hh * 128 + nseg * 16;
            *(u32x4*)orow = w0; *(u32x4*)(orow + 8) = w1;
        }
    }
    __syncthreads();
}

constexpr int NPH = 11;
__global__ void __launch_bounds__(NTHREADS, 2) fwd_kernel(Args args) {
    extern __shared__ __attribute__((aligned(16))) unsigned char lds_raw[];
    LAS unsigned char* lds = (LAS unsigned char*)lds_raw;
    LAS unsigned char* xs = lds + XS_OFF;
    const int tid = threadIdx.x, lane = tid & 63, wave = __builtin_amdgcn_readfirstlane(tid >> 6);
    const int G = gridDim.x, bx = blockIdx.x;
    const int gw = bx * NWAVES + wave, NGW = G * NWAVES;
    unsigned char* ws = args.ws;
    bf16_t* WinT = (bf16_t*)(ws + WS_WIN); bf16_t* WoutT = (bf16_t*)(ws + WS_WOUT); bf16_t* WqB = (bf16_t*)(ws + WS_WQB); bf16_t* WkvT = (bf16_t*)(ws + WS_WKV);
    bf16_t* WoT = (bf16_t*)(ws + WS_WOT); bf16_t* WguT = (bf16_t*)(ws + WS_WGU); bf16_t* WdT = (bf16_t*)(ws + WS_WD);
    bf16_t* MN = (bf16_t*)(ws + WS_MN); bf16_t* KV = (bf16_t*)(ws + WS_KV); bf16_t* MC = (bf16_t*)(ws + WS_MC); bf16_t* VW = (bf16_t*)(ws + WS_VW);
    bf16_t* U = (bf16_t*)(ws + WS_U); bf16_t* P = (bf16_t*)(ws + WS_P); bf16_t* Z = (bf16_t*)(ws + WS_Z);
    float* Y12 = (float*)(ws + WS_Y12); float* Y3 = (float*)(ws + WS_Y3);
    const int lo = args.ph_lo, hi = args.ph_hi;
    cg::grid_group grid = cg::this_grid();
#ifndef PH_MASK
#define PH_MASK 0xfff
#endif
#define IN(k) (((PH_MASK >> (k)) & 1) && lo <= (k) && (k) < hi)
#define SEAM(k) do { if (IN(k) && IN((k) + 1)) grid.sync(); } while (0)

    if (IN(0)) {
        LAS float* scr = (LAS float*)(lds + wave * 16384);
        constexpr int I_IN = 16 * 88, I_SQ = 16 * 32, I_FF = 16 * 88, I_DN = 44 * 32;
        constexpr int NIT = I_IN + 4 * I_SQ + 2 * I_FF + I_DN;
        for (int it = gw; it < NIT; it += NGW) {
            int q = it;
            if (q < I_IN) { const int kb = q / 88, nb = q % 88; transpose_item(args.in[I_WIN], DIN, WinT, D, 64 * kb, 32 * nb, 32 * nb, 1.f, scr, lane); continue; } q -= I_IN;
            if (q < I_SQ) { const int kb = q / 32, nb = q % 32; transpose_item(args.in[I_WOUT], D, WoutT, D, 64 * kb, 32 * nb, 32 * nb, 1.f, scr, lane); continue; } q -= I_SQ;
            if (q < I_SQ) { const int kb = q / 32, nb = q % 32; transpose_item(args.in[I_WK], D, WkvT, D, 64 * kb, 32 * nb, 32 * nb, 1.f, scr, lane); continue; } q -= I_SQ;
            if (q < I_SQ) { const int kb = q / 32, nb = q % 32; transpose_item(args.in[I_WV], D, WkvT, D, 64 * kb, 32 * nb, 1024 + 32 * nb, 1.f, scr, lane); continue; } q -= I_SQ;
            if (q < I_SQ) { const int kb = q / 32, nb = q % 32; transpose_item(args.in[I_WO], D, WoT, D, 64 * kb, 32 * nb, 32 * nb, 1.f, scr, lane); continue; } q -= I_SQ;
            if (q < I_FF) { const int kb = q / 88, nb = q % 88, n0 = 32 * nb; transpose_item(args.in[I_WGATE], DFF, WguT, D, 64 * kb, n0, 256 * (n0 >> 7) + (n0 & 127), 1.f, scr, lane); continue; } q -= I_FF;
            if (q < I_FF) { const int kb = q / 88, nb = q % 88, n0 = 32 * nb; transpose_item(args.in[I_WUP], DFF, WguT, D, 64 * kb, n0, 256 * (n0 >> 7) + 128 + (n0 & 127), 1.f, scr, lane); continue; } q -= I_FF;
            { const int kb = q / 32, nb = q % 32; transpose_item(args.in[I_WDOWN], D, WdT, DFF, 64 * kb, 32 * nb, 32 * nb, 1.f, scr, lane); }
        }
        for (int i = gw * 64 + lane; i < D * D / 4; i += NGW * 64) { const f32x4 v = ((const f32x4*)args.in[I_WQ])[i]; u32x2 w; w.x = pk2(v.x * 0.0625f, v.y * 0.0625f); w.y = pk2(v.z * 0.0625f, v.w * 0.0625f); ((u32x2*)WqB)[i] = w; }
        for (int m = gw; m < MROWS; m += NGW) rms_row_to_bf16(args.in[I_MEM] + (size_t)m * D, args.in[I_GMEM], MN + (size_t)m * D, lane);
        for (int m = gw; m < M; m += NGW) rms_row_to_bf16(args.in[I_X] + (size_t)m * D, args.in[I_GMIXPRE], U + (size_t)m * D, lane);
    }
    SEAM(0);
    if (IN(1)) {
        pg8::ProbG1 g{U, WinT, MN, WkvT, D, D, D}; pg8::OrderG1 S{G, bx}; pg8::EpiBf16 E{Z, DIN, KV, 2048};
        pg8::gemm_phase(lds, xs, g, S, E);
    }
    SEAM(1);
    if (IN(2)) {
        if (bx < 32 && G > 64) { hgrn_seq(lds, Z, P, args.in[I_LB], args.in[I_ONORM], bx, tid); }
        else {
            const int nsw = (G > 64) ? G - 32 : G, c = (G > 64) ? bx - 32 : bx;
            if (G <= 64) { for (int bh = bx; bh < 32; bh += G) hgrn_seq(lds, Z, P, args.in[I_LB], args.in[I_ONORM], bh, tid); }
            for (int it = c; it < 1024; it += nsw) swa_item(lds, Z, P, args.in[I_SINKS], it, tid);
        }
    }
    SEAM(2);
    if (IN(3)) {
#ifndef NO_MC
        { pg8::ProbMcat g{KV, WqB, args.k_small, 2048, 1024}; pg8::OrderLin S{32, 4, G, bx}; pg8::EpiBf16 E{MC, 1024, MC, 1024}; pg8::gemm_phase(lds, xs, g, S, E); }
#endif
#ifndef NO_VW
        { pg8::ProbVW g{WoT, KV, args.k_small, 1024, 2048}; pg8::OrderLin S{32, 4, G, (bx + G / 2) % G}; pg8::EpiBf16 E{VW, 1024, VW, 1024}; pg8::gemm_phase(lds, xs, g, S, E); }
#endif
#ifndef NO_G2
        pg8::ProbPlain g{P, WoutT, D, D, D}; pg8::OrderMN S{128, 4, G, bx}; pg8::EpiF32 E{Y12, D};
        pg8::gemm_phase(lds, xs, g, S, E);
#endif
    }
    SEAM(3);
    if (IN(4)) rownorm_pass(Y12, args.in[I_X], args.out, args.in[I_GMIXPOST], args.in[I_GXPRE], U, gw, NGW, lane);
    SEAM(4);
    if (IN(5)) {
        pg8::ProbBatchB g{U, MC, D, D, D}; pg8::OrderMN S{128, 4, G, bx}; pg8::EpiSoftmax E{P, D};
        pg8::gemm_phase(lds, xs, g, S, E);
    }
    SEAM(5);
    if (IN(6)) {
        pg8::ProbBatchB g{P, VW, D, D, D}; pg8::OrderMN S{128, 4, G, bx}; pg8::EpiF32 E{Y12, D};
        pg8::gemm_phase(lds, xs, g, S, E);
    }
    SEAM(6);
    if (IN(7)) rownorm_pass(Y12, args.out, args.out, args.in[I_GXPOST], args.in[I_GFFNPRE], U, gw, NGW, lane);
    SEAM(7);
    if (IN(8)) {
        pg8::ProbPlain g{U, WguT, D, D, D}; pg8::OrderMN S{128, 22, G, bx}; pg8::EpiSwiGLU E{Z, DFF};
        pg8::gemm_phase(lds, xs, g, S, E);
    }
    SEAM(8);
    if (IN(9)) {
        pg8::ProbPlain g{Z, WdT, DFF, DFF, DFF}; pg8::OrderMN S{128, 4, G, bx}; pg8::EpiF32 E{Y3, D};
        pg8::gemm_phase(lds, xs, g, S, E);
    }
    SEAM(9);
    if (IN(10)) rownorm_pass(Y3, args.out, args.out, args.in[I_GFFNPOST], nullptr, nullptr, gw, NGW, lane);
#undef IN
#undef SEAM
}

extern "C" void kernel_launch(void* const* d_in, const int* in_sizes, int n_in, void* d_out, int out_size, void* d_ws, size_t ws_size, hipStream_t stream) {
    static int grid = 0;
    if (grid == 0) {
        if (n_in != 21 || out_size != M * D || ws_size < WS_END) { fprintf(stderr, "kernel_launch: unexpected problem (n_in %d out %d ws %zu)\n", n_in, out_size, ws_size); grid = -1; return; }
        int dev = 0, cus = 0, per_cu = 0;
        hipGetDevice(&dev); hipDeviceGetAttribute(&cus, hipDeviceAttributeMultiprocessorCount, dev);
        if (hipFuncSetAttribute((const void*)fwd_kernel, hipFuncAttributeMaxDynamicSharedMemorySize, LDS_BYTES) != hipSuccess) { fprintf(stderr, "kernel_launch: hipFuncSetAttribute failed\n"); grid = -1; return; }
        hipOccupancyMaxActiveBlocksPerMultiprocessor(&per_cu, (const void*)fwd_kernel, NTHREADS, LDS_BYTES);
        (void)hipGetLastError();
        if (per_cu < 1) { fprintf(stderr, "kernel_launch: occupancy query says %d blocks per CU\n", per_cu); per_cu = 1; }
        grid = cus;
    }
    if (grid < 0) return;
    Args a{};
    for (int i = 0; i < 21; ++i) a.in[i] = (const float*)d_in[i];
    a.out = (float*)d_out; a.ws = (unsigned char*)d_ws; a.k_small = 256;
#if MK_PER_PHASE
    for (int p = 0; p < NPH; ++p) { a.ph_lo = p; a.ph_hi = p + 1; hipLaunchKernelGGL(fwd_kernel, dim3(grid), dim3(NTHREADS), LDS_BYTES, stream, a); }
#else
    a.ph_lo = 0; a.ph_hi = NPH;
    void* kargs[] = {&a};
    hipError_t e = hipLaunchCooperativeKernel((const void*)fwd_kernel, dim3(grid), dim3(NTHREADS), kargs, LDS_BYTES, stream);
    if (e != hipSuccess) fprintf(stderr, "cooperative launch failed: %s (grid %d)\n", hipGetErrorString(e), grid);
#endif
}
```

```cpp
#include <hip/hip_runtime.h>
#include <hip/hip_cooperative_groups.h>
#include <cstdio>
#include <cstdint>
namespace cg = cooperative_groups;

#define LAS __attribute__((address_space(3)))
#define GAS __attribute__((address_space(1)))
typedef unsigned short bf16_t;
typedef short bf16x8 __attribute__((ext_vector_type(8)));
typedef short s16x4 __attribute__((ext_vector_type(4)));
typedef float f32x2 __attribute__((ext_vector_type(2)));
typedef float f32x4 __attribute__((ext_vector_type(4)));
typedef float f32x16 __attribute__((ext_vector_type(16)));
typedef unsigned u32x2 __attribute__((ext_vector_type(2)));
typedef unsigned u32x4 __attribute__((ext_vector_type(4)));
typedef __bf16 bf16x2_t __attribute__((ext_vector_type(2)));

#ifndef MK_PER_PHASE
#define MK_PER_PHASE 0
#endif

constexpr int BATCH = 8, T = 4096, D = 1024, M = BATCH * T;
constexpr int DIN = 2816, DFF = 2816, MEM = 256, MROWS = BATCH * MEM;
constexpr int ZQA = 0, ZKA = 512, ZVA = 640, ZQB = 768, ZFB = 1280, ZIB = 1792, ZGB = 2304;
constexpr float RMS_EPS = 1e-6f;
constexpr int NWAVES = 8, NTHREADS = 512;

constexpr size_t MiB = 1u << 20;
constexpr size_t WS_WIN = 2 * MiB;
constexpr size_t WS_WOUT = 8 * MiB;
constexpr size_t WS_WQB = 10 * MiB;
constexpr size_t WS_WKV = 12 * MiB;
constexpr size_t WS_WOT = 16 * MiB;
constexpr size_t WS_WGU = 18 * MiB;
constexpr size_t WS_WD = 30 * MiB;
constexpr size_t WS_MN = 36 * MiB;
constexpr size_t WS_KV = 40 * MiB;
constexpr size_t WS_MC = 48 * MiB;
constexpr size_t WS_VW = 64 * MiB;
constexpr size_t WS_U = 96 * MiB;
constexpr size_t WS_P = 160 * MiB;
constexpr size_t WS_Z = 224 * MiB;
constexpr size_t WS_REC = 400 * MiB;
constexpr size_t WS_IT = WS_U;
constexpr size_t WS_END = 484 * MiB;
constexpr size_t WS_Y12 = WS_Z;
constexpr size_t WS_Y3 = WS_U;

constexpr int RING_BYTES = 131072;
constexpr int XS_OFF = RING_BYTES;
constexpr int LDS_BYTES = 147456;

__device__ __forceinline__ unsigned pk2(float lo, float hi) { f32x2 v = {lo, hi}; bf16x2_t b = __builtin_convertvector(v, bf16x2_t); return __builtin_bit_cast(unsigned, b); }
__device__ __forceinline__ float bf_lo(unsigned u) { return __uint_as_float(u << 16); }
__device__ __forceinline__ float bf_hi(unsigned u) { return __uint_as_float(u & 0xffff0000u); }
__device__ __forceinline__ float wave_sum(float v) {
#pragma unroll
    for (int o = 1; o < 64; o <<= 1) v += __shfl_xor(v, o);
    return v;
}
__device__ __forceinline__ float fast_exp2(float x) { return __builtin_amdgcn_exp2f(x); }
__device__ __forceinline__ float fast_rcp(float x) { return __builtin_amdgcn_rcpf(x); }
__device__ __forceinline__ float sigmoidf_(float x) { return fast_rcp(1.0f + fast_exp2(-1.4426950408889634f * x)); }
#define LDS_WAIT() asm volatile("s_waitcnt lgkmcnt(0)" ::: "memory")
#define MFMA32(a, b, c) __builtin_amdgcn_mfma_f32_32x32x16_bf16((a), (b), (c), 0, 0, 0)

namespace pg8 {
constexpr int BM = 256, BK = 64, HALF = 128, HTB = HALF * BK * 2, NXCD = 8, WGM = 8;
__host__ __device__ __forceinline__ int lds_byte(int r, int c) { const int st = (r >> 4) * 2 + (c >> 5), rr = r & 15, cc = c & 31, ob = rr * 64 + cc * 2; return st * 1024 + (ob ^ (((ob >> 9) & 1) << 5)); }
__host__ __device__ __forceinline__ void stage_rc(int b, int& R, int& C) { const int st = b / 1024, sb = b % 1024, swz = sb ^ (((sb >> 9) & 1) << 5); R = (st >> 1) * 16 + swz / 64; C = (st & 1) * 32 + (swz % 64) / 2; }
__host__ __device__ __forceinline__ int perm32(int rho) { const int n = rho >> 4, i = rho & 15; return 8 * (i >> 2) + 4 * n + (i & 3); }

struct Unit { int pm, pn, kind; };

__device__ __forceinline__ void tile_of(int L, int nM, int nN, int& pm, int& pn) {
    const int nwg = nM * nN; int wgid = L;
    { const int q = nwg / NXCD, r = nwg % NXCD, xcd = wgid % NXCD, off = wgid / NXCD; wgid = (xcd < r ? xcd * (q + 1) : r * (q + 1) + (xcd - r) * q) + off; }
    const int nig = WGM * nN, gid = wgid / nig, fm = gid * WGM, gsz = (nM - fm) < WGM ? (nM - fm) : WGM;
    pm = fm + ((wgid % nig) % gsz); pn = (wgid % nig) / gsz;
}
struct OrderMN {
    int nM, nN, G, c;
    __device__ __forceinline__ bool next(int i, Unit& u) const { const int L = i * G + c; if (c < 0 || L >= nM * nN) return false; tile_of(L, nM, nN, u.pm, u.pn); u.kind = 0; return true; }
};
struct OrderG1 {
    int G, c;
    __device__ __forceinline__ bool next(int i, Unit& u) const {
        const int L = i * G + c;
        if (L < 128 * 11) { tile_of(L, 128, 11, u.pm, u.pn); u.kind = 0; return true; }
        const int L2 = L - 128 * 11; if (L2 >= 64) return false;
        u.pm = L2 >> 3; u.pn = L2 & 7; u.kind = 1; return true;
    }
};
struct OrderLin {
    int nM, nN, G, c;
    __device__ __forceinline__ bool next(int i, Unit& u) const { const int L = i * G + c; if (c < 0 || L >= nM * nN) return false; u.pm = L / nN; u.pn = L % nN; u.kind = 0; return true; }
};

struct ProbPlain { const bf16_t* A; const bf16_t* Bt; int K, lda, ldb;
    __device__ __forceinline__ const char* a_ptr(const Unit& u) const { return (const char*)(A + (size_t)u.pm * 256 * lda); }
    __device__ __forceinline__ const char* b_ptr(const Unit& u) const { return (const char*)(Bt + (size_t)u.pn * 256 * ldb); } };
struct ProbG1 { const bf16_t* A0; const bf16_t* B0; const bf16_t* A1; const bf16_t* B1; int K, lda, ldb;
    __device__ __forceinline__ const char* a_ptr(const Unit& u) const { return (const char*)((u.kind ? A1 : A0) + (size_t)u.pm * 256 * lda); }
    __device__ __forceinline__ const char* b_ptr(const Unit& u) const { return (const char*)((u.kind ? B1 : B0) + (size_t)u.pn * 256 * ldb); } };
struct ProbBatchB { const bf16_t* A; const bf16_t* Bt; int K, lda, ldb;
    __device__ __forceinline__ const char* a_ptr(const Unit& u) const { return (const char*)(A + (size_t)u.pm * 256 * lda); }
    __device__ __forceinline__ const char* b_ptr(const Unit& u) const { return (const char*)(Bt + (size_t)(u.pm >> 4) * 1024 * 1024 + (size_t)u.pn * 256 * ldb); } };
struct ProbMcat { const bf16_t* KV; const bf16_t* WqB; int K, lda, ldb;
    __device__ __forceinline__ const char* a_ptr(const Unit& u) const { return (const char*)(KV + (size_t)(u.pm >> 2) * 256 * 2048 + (u.pm & 3) * 256); }
    __device__ __forceinline__ const char* b_ptr(const Unit& u) const { return (const char*)(WqB + (size_t)u.pn * 256 * 1024 + (u.pm & 3) * 256); } };
struct ProbVW { const bf16_t* WoT; const bf16_t* KV; int K, lda, ldb;
    __device__ __forceinline__ const char* a_ptr(const Unit& u) const { return (const char*)(WoT + (size_t)(u.pm & 3) * 256 * 1024 + u.pn * 256); }
    __device__ __forceinline__ const char* b_ptr(const Unit& u) const { return (const char*)(KV + (size_t)(u.pm >> 2) * 256 * 2048 + 1024 + u.pn * 256); } };

struct EpiBf16 {
    static constexpr bool PERM = true, NEEDS_BAR = false;
    bf16_t* O0; int ldc0; bf16_t* O1; int ldc1;
    __device__ __forceinline__ void operator()(f32x4 (&acc)[2][2][4][2], const Unit& u, int wr, int wc, int fr, int fq, LAS unsigned char*) const {
        bf16_t* O = u.kind ? O1 : O0; const int ldc = u.kind ? ldc1 : ldc0;
        const int row0 = u.pm * BM + wr * 64 + fr, col0 = u.pn * BM + wc * 32 + 8 * fq;
#pragma unroll
        for (int ai = 0; ai < 2; ++ai)
#pragma unroll
            for (int m = 0; m < 4; ++m) { bf16_t* rowp = O + (size_t)(row0 + ai * HALF + m * 16) * ldc + col0;
#pragma unroll
                for (int bj = 0; bj < 2; ++bj) { const f32x4 v0 = acc[ai][bj][m][0], v1 = acc[ai][bj][m][1];
                    u32x4 w; w.x = pk2(v0[0], v0[1]); w.y = pk2(v0[2], v0[3]); w.z = pk2(v1[0], v1[1]); w.w = pk2(v1[2], v1[3]);
                    *(u32x4*)(rowp + bj * HALF) = w; } }
    }
};
struct EpiF32 {
    static constexpr bool PERM = true, NEEDS_BAR = false;
    float* O; int ldc;
    __device__ __forceinline__ void operator()(f32x4 (&acc)[2][2][4][2], const Unit& u, int wr, int wc, int fr, int fq, LAS unsigned char*) const {
        const int row0 = u.pm * BM + wr * 64 + fr, col0 = u.pn * BM + wc * 32 + 8 * fq;
#pragma unroll
        for (int ai = 0; ai < 2; ++ai)
#pragma unroll
            for (int m = 0; m < 4; ++m) { float* rowp = O + (size_t)(row0 + ai * HALF + m * 16) * ldc + col0;
#pragma unroll
                for (int bj = 0; bj < 2; ++bj) { *(f32x4*)(rowp + bj * HALF) = acc[ai][bj][m][0]; *(f32x4*)(rowp + bj * HALF + 4) = acc[ai][bj][m][1]; } }
    }
};
struct EpiSwiGLU {
    static constexpr bool PERM = true, NEEDS_BAR = false;
    bf16_t* O; int ldc;
    __device__ __forceinline__ void operator()(f32x4 (&acc)[2][2][4][2], const Unit& u, int wr, int wc, int fr, int fq, LAS unsigned char*) const {
        const int row0 = u.pm * BM + wr * 64 + fr, col0 = u.pn * HALF + wc * 32 + 8 * fq;
#pragma unroll
        for (int ai = 0; ai < 2; ++ai)
#pragma unroll
            for (int m = 0; m < 4; ++m) { bf16_t* rowp = O + (size_t)(row0 + ai * HALF + m * 16) * ldc + col0;
                float o[8];
#pragma unroll
                for (int n = 0; n < 2; ++n)
#pragma unroll
                    for (int j = 0; j < 4; ++j) { const float g = acc[ai][0][m][n][j], up = acc[ai][1][m][n][j]; o[n * 4 + j] = g * sigmoidf_(g) * up; }
                u32x4 w; w.x = pk2(o[0], o[1]); w.y = pk2(o[2], o[3]); w.z = pk2(o[4], o[5]); w.w = pk2(o[6], o[7]);
                *(u32x4*)rowp = w; }
    }
};
struct EpiSoftmax {
    static constexpr bool PERM = true, NEEDS_BAR = true;
    bf16_t* O; int ldc;
    __device__ __forceinline__ void operator()(f32x4 (&acc)[2][2][4][2], const Unit& u, int wr, int wc, int fr, int fq, LAS unsigned char* xs) const {
        LAS f32x2* XS = (LAS f32x2*)xs;
        float mw[2][4];
#pragma unroll
        for (int ai = 0; ai < 2; ++ai)
#pragma unroll
            for (int m = 0; m < 4; ++m) {
                float mx = -3.0e38f;
#pragma unroll
                for (int bj = 0; bj < 2; ++bj)
#pragma unroll
                    for (int n = 0; n < 2; ++n) { const f32x4 x = acc[ai][bj][m][n]; mx = fmaxf(mx, fmaxf(fmaxf(x[0], x[1]), fmaxf(x[2], x[3]))); }
                mx = fmaxf(mx, __shfl_xor(mx, 16)); mx = fmaxf(mx, __shfl_xor(mx, 32));
                float s = 0.f;
#pragma unroll
                for (int bj = 0; bj < 2; ++bj)
#pragma unroll
                    for (int n = 0; n < 2; ++n) { f32x4 x = acc[ai][bj][m][n];
#pragma unroll
                        for (int j = 0; j < 4; ++j) { x[j] = fast_exp2((x[j] - mx) * 1.4426950408889634f); s += x[j]; }
                        acc[ai][bj][m][n] = x; }
                s += __shfl_xor(s, 16); s += __shfl_xor(s, 32);
                mw[ai][m] = mx;
                if (fq == 0) XS[(ai * HALF + wr * 64 + m * 16 + fr) * 4 + wc] = (f32x2){mx, s};
            }
        asm volatile("s_waitcnt lgkmcnt(0)" ::: "memory"); __builtin_amdgcn_s_barrier(); asm volatile("" ::: "memory");
        const int row0 = u.pm * BM + wr * 64 + fr, col0 = u.pn * BM + wc * 32 + 8 * fq;
#pragma unroll
        for (int ai = 0; ai < 2; ++ai)
#pragma unroll
            for (int m = 0; m < 4; ++m) {
                const int rl = ai * HALF + wr * 64 + m * 16 + fr;
                const f32x2 a = XS[rl * 4 + 0], b = XS[rl * 4 + 1], c = XS[rl * 4 + 2], d = XS[rl * 4 + 3];
                const float MX = fmaxf(fmaxf(a.x, b.x), fmaxf(c.x, d.x));
                const float L = a.y * fast_exp2((a.x - MX) * 1.4426950408889634f) + b.y * fast_exp2((b.x - MX) * 1.4426950408889634f)
                              + c.y * fast_exp2((c.x - MX) * 1.4426950408889634f) + d.y * fast_exp2((d.x - MX) * 1.4426950408889634f);
                const float f = fast_exp2((mw[ai][m] - MX) * 1.4426950408889634f) / L;
                bf16_t* rowp = O + (size_t)(row0 + ai * HALF + m * 16) * ldc + col0;
#pragma unroll
                for (int bj = 0; bj < 2; ++bj) { const f32x4 v0 = acc[ai][bj][m][0] * f, v1 = acc[ai][bj][m][1] * f;
                    u32x4 w; w.x = pk2(v0[0], v0[1]); w.y = pk2(v0[2], v0[3]); w.z = pk2(v1[0], v1[1]); w.w = pk2(v1[2], v1[3]);
                    *(u32x4*)(rowp + bj * HALF) = w; }
            }
    }
};

template <class Prob, class Epi, class Sched>
__device__ __forceinline__ void gemm_phase(LAS unsigned char* lds, LAS unsigned char* xs, const Prob g, const Sched& S, const Epi& E) {
    const int tid = threadIdx.x, wid = __builtin_amdgcn_readfirstlane(tid >> 6), lane = tid & 63, wr = wid >> 2, wc = wid & 3, fr = lane & 15, fq = lane >> 4;
    const int K = g.K, nt = K / BK;
    unsigned voffA[2], voffB[2];
#pragma unroll
    for (int i = 0; i < 2; ++i) { int R, C; stage_rc(tid * 16 + i * 8192, R, C); const int Rb = Epi::PERM ? ((R & ~31) + perm32(R & 31)) : R;
        voffA[i] = (unsigned)(R * g.lda + C) * 2u; voffB[i] = (unsigned)(Rb * g.ldb + C) * 2u; }
    const size_t kstep = (size_t)(BK * 2);
    const size_t hstepA = (size_t)HALF * g.lda * 2, hstepB = (size_t)HALF * g.ldb * 2;
    const unsigned ldsw = (unsigned)wid * 1024u;
    const int aoff = lds_byte(wr * 64 + fr, fq * 8), boff = lds_byte(wc * 32 + fr, fq * 8);
#define PG8_SA(b, h) (((b) * 2 + (h)) * HTB)
#define PG8_SB(b, h) ((4 + (b) * 2 + (h)) * HTB)
#define PG8_STAGE(bufoff, gbase, voff) do { _Pragma("unroll") for (int _i = 0; _i < 2; ++_i) \
        __builtin_amdgcn_global_load_lds((const unsigned*)((const char*)(gbase) + (voff)[_i]), (LAS unsigned*)(lds + (bufoff) + ldsw + _i * 8192), 16, 0, 0); } while (0)
#define PG8_LDA(dst, b, h) do { _Pragma("unroll") for (int m = 0; m < 4; ++m) _Pragma("unroll") for (int k = 0; k < 2; ++k) dst[m][k] = *(const LAS bf16x8*)(lds + PG8_SA(b, h) + aoff + m * 2048 + k * 1024); } while (0)
#define PG8_LDB(dst, b, h) do { _Pragma("unroll") for (int n = 0; n < 2; ++n) _Pragma("unroll") for (int k = 0; k < 2; ++k) dst[n][k] = *(const LAS bf16x8*)(lds + PG8_SB(b, h) + boff + n * 2048 + k * 1024); } while (0)
#define PG8_MMA(ai, bj, At, Bt) do { __builtin_amdgcn_s_setprio(1); _Pragma("unroll") for (int m = 0; m < 4; ++m) _Pragma("unroll") for (int n = 0; n < 2; ++n) _Pragma("unroll") for (int k = 0; k < 2; ++k) \
        acc[ai][bj][m][n] = __builtin_amdgcn_mfma_f32_16x16x32_bf16(Bt[n][k], At[m][k], acc[ai][bj][m][n], 0, 0, 0); __builtin_amdgcn_s_setprio(0); } while (0)
#define PG8_WAIT_V(n) asm volatile("s_waitcnt vmcnt(" #n ")" ::: "memory")
#define PG8_WAIT_L(n) asm volatile("s_waitcnt lgkmcnt(" #n ")" ::: "memory")
#define PG8_BAR __builtin_amdgcn_s_barrier()
#define PG8_SCHED __builtin_amdgcn_sched_barrier(0)
    Unit cur, nxt; int ui = 0;
    if (!S.next(0, cur)) return;
    f32x4 acc[2][2][4][2];
#pragma unroll
    for (int a = 0; a < 2; ++a)
#pragma unroll
        for (int b = 0; b < 2; ++b)
#pragma unroll
            for (int m = 0; m < 4; ++m)
#pragma unroll
                for (int n = 0; n < 2; ++n) acc[a][b][m][n] = (f32x4){0.f, 0.f, 0.f, 0.f};
    bf16x8 At[4][2], B0[2][2], B1[2][2];
    const char* cA = g.a_ptr(cur); const char* cB = g.b_ptr(cur);
    PG8_STAGE(PG8_SB(0, 0), cB, voffB); PG8_STAGE(PG8_SB(0, 1), cB + hstepB, voffB); PG8_STAGE(PG8_SA(0, 0), cA, voffA); PG8_STAGE(PG8_SA(0, 1), cA + hstepA, voffA);
    if (wr == 1) PG8_BAR;
    PG8_WAIT_V(2); PG8_BAR;
    PG8_STAGE(PG8_SB(1, 0), cB + kstep, voffB); PG8_STAGE(PG8_SA(1, 0), cA + kstep, voffA); PG8_STAGE(PG8_SB(1, 1), cB + hstepB + kstep, voffB);
    PG8_WAIT_V(6); PG8_BAR;
    for (;;) {
        const bool has_next = S.next(ui + 1, nxt);
        const char* nA = has_next ? g.a_ptr(nxt) : cA; const char* nB = has_next ? g.b_ptr(nxt) : cB;
        for (int t = 0; t < nt; t += 2) {
            const bool last = (t == nt - 2);
            const char* a1 = cA + (size_t)(t + 1) * kstep;
            const char* a2 = last ? nA : cA + (size_t)(t + 2) * kstep; const char* b2 = last ? nB : cB + (size_t)(t + 2) * kstep;
            const char* a3 = a2 + kstep; const char* b3 = b2 + kstep;
            PG8_LDB(B0, 0, 0); PG8_LDB(B1, 0, 1); PG8_SCHED; PG8_LDA(At, 0, 0); PG8_STAGE(PG8_SA(1, 1), a1 + hstepA, voffA);
            PG8_WAIT_V(8); PG8_WAIT_L(0); PG8_BAR; PG8_MMA(0, 0, At, B0); PG8_MMA(0, 1, At, B1); PG8_BAR; PG8_SCHED;
            PG8_LDA(At, 0, 1); PG8_STAGE(PG8_SB(0, 0), b2, voffB); PG8_STAGE(PG8_SB(0, 1), b2 + hstepB, voffB); PG8_STAGE(PG8_SA(0, 0), a2, voffA);
            PG8_WAIT_V(8); PG8_WAIT_L(0); PG8_BAR; PG8_MMA(1, 0, At, B0); PG8_MMA(1, 1, At, B1); PG8_BAR; PG8_SCHED;
            PG8_LDB(B0, 1, 0); PG8_LDB(B1, 1, 1); PG8_SCHED; PG8_LDA(At, 1, 0); PG8_STAGE(PG8_SA(0, 1), a2 + hstepA, voffA);
            PG8_WAIT_V(8); PG8_WAIT_L(0); PG8_BAR; PG8_MMA(0, 0, At, B0); PG8_MMA(0, 1, At, B1); PG8_BAR; PG8_SCHED;
            PG8_LDA(At, 1, 1); PG8_STAGE(PG8_SB(1, 0), b3, voffB); PG8_STAGE(PG8_SB(1, 1), b3 + hstepB, voffB); PG8_STAGE(PG8_SA(1, 0), a3, voffA);
            PG8_WAIT_V(8); PG8_WAIT_L(0); PG8_BAR; PG8_MMA(1, 0, At, B0); PG8_MMA(1, 1, At, B1); PG8_BAR; PG8_SCHED;
        }
        if (wr == 0) PG8_BAR;
        E(acc, cur, wr, wc, fr, fq, xs);
        if (!has_next) break;
#pragma unroll
        for (int a = 0; a < 2; ++a)
#pragma unroll
            for (int b = 0; b < 2; ++b)
#pragma unroll
                for (int m = 0; m < 4; ++m)
#pragma unroll
                    for (int n = 0; n < 2; ++n) acc[a][b][m][n] = (f32x4){0.f, 0.f, 0.f, 0.f};
        cur = nxt; cA = nA; cB = nB; ++ui;
        if (wr == 1) PG8_BAR;
    }
    PG8_WAIT_V(0);
    PG8_BAR;
#undef PG8_SA
#undef PG8_SB
#undef PG8_STAGE
#undef PG8_LDA
#undef PG8_LDB
#undef PG8_MMA
#undef PG8_WAIT_V
#undef PG8_WAIT_L
#undef PG8_BAR
#undef PG8_SCHED
}
}

struct Args {
    const float* in[21];
    float* out; unsigned char* ws;
    int ph_lo, ph_hi, k_small, pad;
};
enum { I_X = 0, I_MEM, I_WIN, I_SINKS, I_LB, I_ONORM, I_WOUT, I_GMIXPRE, I_GMIXPOST, I_GMEM, I_GXPRE, I_GXPOST, I_WQ, I_WK, I_WV, I_WO, I_GFFNPRE, I_GFFNPOST, I_WGATE, I_WUP, I_WDOWN };

__device__ __forceinline__ void transpose_item(const float* W, int N, bf16_t* WT, int ldt, int k0, int n0, int dst_row0, float scale, LAS float* scr, int lane) {
#pragma unroll 8
    for (int i = 0; i < 32; ++i) { const int kk = 2 * i + (lane >> 5); scr[kk * 33 + (lane & 31)] = W[(size_t)(k0 + kk) * N + n0 + (lane & 31)] * scale; }
    LDS_WAIT(); asm volatile("" ::: "memory");
    const int c = lane & 7;
#pragma unroll
    for (int j = 0; j < 4; ++j) { const int n = (lane >> 3) + 8 * j; const LAS float* s = scr + (8 * c) * 33 + n;
        u32x4 o; o.x = pk2(s[0 * 33], s[1 * 33]); o.y = pk2(s[2 * 33], s[3 * 33]); o.z = pk2(s[4 * 33], s[5 * 33]); o.w = pk2(s[6 * 33], s[7 * 33]);
        *(u32x4*)(WT + (size_t)(dst_row0 + n) * ldt + k0 + 8 * c) = o; }
    LDS_WAIT(); asm volatile("" ::: "memory");
}
__device__ __forceinline__ void rms_row_to_bf16(const float* xrow, const float* g, bf16_t* orow, int lane) {
    const f32x4* xr = (const f32x4*)xrow + lane; const f32x4* gr = (const f32x4*)g + lane;
    f32x4 v[4]; float s = 0.f;
#pragma unroll
    for (int j = 0; j < 4; ++j) { v[j] = xr[64 * j]; s += (v[j].x * v[j].x + v[j].y * v[j].y) + (v[j].z * v[j].z + v[j].w * v[j].w); }
    const float rstd = 1.0f / sqrtf(wave_sum(s) * (1.f / D) + RMS_EPS);
    u32x2* o8 = (u32x2*)orow + lane;
#pragma unroll
    for (int j = 0; j < 4; ++j) { const f32x4 gg = gr[64 * j]; u32x2 w; w.x = pk2(v[j].x * rstd * gg.x, v[j].y * rstd * gg.y); w.y = pk2(v[j].z * rstd * gg.z, v[j].w * rstd * gg.w); o8[64 * j] = w; }
}
__device__ __forceinline__ void rownorm_pass(const float* y, const float* hin, float* hout, const float* gpost, const float* gpre, bf16_t* uout, int gw, int NGW, int lane) {
    f32x4 gp[4], gq[4];
#pragma unroll
    for (int j = 0; j < 4; ++j) { gp[j] = ((const f32x4*)gpost)[lane + 64 * j]; gq[j] = gpre ? ((const f32x4*)gpre)[lane + 64 * j] : (f32x4){0.f, 0.f, 0.f, 0.f}; }
    for (int m = gw; m < M; m += NGW) {
        const f32x4* yr = (const f32x4*)(y + (size_t)m * D) + lane; const f32x4* hr = (const f32x4*)(hin + (size_t)m * D) + lane;
        f32x4 yv[4], hv[4]; float s = 0.f;
#pragma unroll
        for (int j = 0; j < 4; ++j) { yv[j] = yr[64 * j]; hv[j] = hr[64 * j]; s += (yv[j].x * yv[j].x + yv[j].y * yv[j].y) + (yv[j].z * yv[j].z + yv[j].w * yv[j].w); }
        const float r1 = 1.0f / sqrtf(wave_sum(s) * (1.f / D) + RMS_EPS);
        float s2 = 0.f; f32x4* ho = (f32x4*)(hout + (size_t)m * D) + lane;
#pragma unroll
        for (int j = 0; j < 4; ++j) { hv[j] = hv[j] + yv[j] * r1 * gp[j]; ho[64 * j] = hv[j]; s2 += (hv[j].x * hv[j].x + hv[j].y * hv[j].y) + (hv[j].z * hv[j].z + hv[j].w * hv[j].w); }
        if (uout) {
            const float r2 = 1.0f / sqrtf(wave_sum(s2) * (1.f / D) + RMS_EPS);
            u32x2* o8 = (u32x2*)(uout + (size_t)m * D) + lane;
#pragma unroll
            for (int j = 0; j < 4; ++j) { u32x2 w; w.x = pk2(hv[j].x * r2 * gq[j].x, hv[j].y * r2 * gq[j].y); w.y = pk2(hv[j].z * r2 * gq[j].z, hv[j].w * r2 * gq[j].w); o8[64 * j] = w; }
        }
    }
}

__device__ __forceinline__ void swa_item(LAS unsigned char* lds, const bf16_t* Z, bf16_t* YM, const float* sinks, int item, int tid) {
    const int kvh = item & 1, n = (item >> 1) & 63, b = item >> 7;
    const int wave = tid >> 6, lane = tid & 63, r = lane & 31, h = lane >> 5;
    constexpr int KST = 144, VST = 392;
    LAS unsigned char* Ks = lds;
    LAS unsigned char* Vt = lds + 192 * KST;
    const long tok0 = (long)b * T + (long)(n - 2) * 64;
    for (int id = tid; id < 1536; id += NTHREADS) {
        const int key = id >> 3, c = id & 7; const int ch = n - 2 + (key >> 6);
        u32x4 kq = {0u, 0u, 0u, 0u}, vq = {0u, 0u, 0u, 0u};
        if (ch >= 0) { const bf16_t* row = Z + (size_t)(tok0 + key) * DIN; kq = *(const u32x4*)(row + ZKA + kvh * 64 + c * 8); vq = *(const u32x4*)(row + ZVA + kvh * 64 + c * 8); }
        *(LAS u32x4*)(Ks + key * KST + c * 16) = kq;
#pragma unroll
        for (int i = 0; i < 8; ++i) { const unsigned w = vq[i >> 1]; *(LAS unsigned short*)(Vt + (c * 8 + i) * VST + key * 2) = (unsigned short)((i & 1) ? (w >> 16) : (w & 0xffffu)); }
    }
    const int hq = kvh * 4 + (wave >> 1);
    const size_t tq = (size_t)b * T + n * 64 + (wave & 1) * 32 + r;
    bf16x8 qf[4];
#pragma unroll
    for (int s = 0; s < 4; ++s) qf[s] = *(const bf16x8*)(Z + tq * DIN + ZQA + hq * 64 + 16 * s + 8 * h);
    const float sink = sinks[hq];
    __syncthreads();
    f32x16 st[6];
#pragma unroll
    for (int kt = 0; kt < 6; ++kt) {
#pragma unroll
        for (int i = 0; i < 16; ++i) st[kt][i] = 0.f;
#pragma unroll
        for (int s = 0; s < 4; ++s) { const bf16x8 a = *(const LAS bf16x8*)(Ks + (kt * 32 + r) * KST + (16 * s + 8 * h) * 2); st[kt] = MFMA32(a, qf[s], st[kt]); }
    }
    const bool v0 = n >= 2, v1 = n >= 1;
    float mx = sink;
#pragma unroll
    for (int kt = 0; kt < 6; ++kt) { const bool valid = kt < 2 ? v0 : (kt < 4 ? v1 : true);
        if (valid) {
#pragma unroll
            for (int i = 0; i < 16; ++i) { st[kt][i] *= 0.125f; mx = fmaxf(mx, st[kt][i]); } } }
    mx = fmaxf(mx, __shfl_xor(mx, 32));
    float sum = 0.f;
#pragma unroll
    for (int kt = 0; kt < 6; ++kt) { const bool valid = kt < 2 ? v0 : (kt < 4 ? v1 : true);
#pragma unroll
        for (int i = 0; i < 16; ++i) { const float p = valid ? fast_exp2((st[kt][i] - mx) * 1.4426950408889634f) : 0.f; st[kt][i] = p; sum += p; } }
    sum += __shfl_xor(sum, 32);
    sum += fast_exp2((sink - mx) * 1.4426950408889634f);
    const float inv = 1.0f / sum;
    f32x16 o[2];
#pragma unroll
    for (int dt = 0; dt < 2; ++dt)
#pragma unroll
        for (int i = 0; i < 16; ++i) o[dt][i] = 0.f;
#pragma unroll
    for (int kt = 0; kt < 6; ++kt)
#pragma unroll
        for (int s = 0; s < 2; ++s) {
            u32x4 pw; pw.x = pk2(st[kt][8 * s + 0], st[kt][8 * s + 1]); pw.y = pk2(st[kt][8 * s + 2], st[kt][8 * s + 3]); pw.z = pk2(st[kt][8 * s + 4], st[kt][8 * s + 5]); pw.w = pk2(st[kt][8 * s + 6], st[kt][8 * s + 7]);
            const bf16x8 pb = __builtin_bit_cast(bf16x8, pw);
#pragma unroll
            for (int dt = 0; dt < 2; ++dt) {
                const LAS unsigned char* vp = Vt + (dt * 32 + r) * VST + (kt * 32 + 16 * s + 4 * h) * 2;
                u32x4 aw; const u32x2 a0 = *(const LAS u32x2*)vp, a1 = *(const LAS u32x2*)(vp + 16); aw.x = a0.x; aw.y = a0.y; aw.z = a1.x; aw.w = a1.y;
                o[dt] = MFMA32(__builtin_bit_cast(bf16x8, aw), pb, o[dt]);
            }
        }
    bf16_t* orow = YM + tq * D + hq * 64;
#pragma unroll
    for (int dt = 0; dt < 2; ++dt)
#pragma unroll
        for (int g = 0; g < 4; ++g) { u32x2 w; w.x = pk2(o[dt][4 * g] * inv, o[dt][4 * g + 1] * inv); w.y = pk2(o[dt][4 * g + 2] * inv, o[dt][4 * g + 3] * inv);
            *(u32x2*)(orow + 32 * dt + 8 * g + 4 * h) = w; }
    __syncthreads();
}

constexpr int HG_QD = 0, HG_KD = 17408, HG_QB = 34816, HG_KLT = 52224, HG_IT = 70656, HG_AM = 89088, HG_OB1 = 98304, HG_PART = 132096, HG_DEC = 136192;
constexpr int HG_OB0 = 0;
constexpr int RS = 272, TS = 144, OS = 528;
constexpr int RECB = 41984;
static_assert(HG_DEC + 512 <= LDS_BYTES, "hgrn lds");
__device__ __forceinline__ void hgrn_prep_item(LAS unsigned char* lds, const bf16_t* Z, const float* lbp, unsigned char* REC, unsigned char* ITG, int item, int tid) {
    const int c = item & 63, bh = item >> 6, b = bh >> 2, hh = bh & 3;
    const int wave = tid >> 6, lane = tid & 63, r = lane & 31, h = lane >> 5;
    const int cp = tid & 63, rg = tid >> 6;
    float lbv[2];
#pragma unroll
    for (int e = 0; e < 2; ++e) { const float a0 = lbp[hh * 128 + 2 * cp + e], a1 = lbp[512 + hh * 128 + 2 * cp + e]; lbv[e] = 1.0f / (1.0f + __expf(a1 - a0)); }
    LAS float* PART = (LAS float*)(lds + HG_PART);
    LAS float* DEC = (LAS float*)(lds + HG_DEC);
    const size_t tokc = (size_t)b * T + (size_t)c * 64;
    unsigned qv[8], fv[8], iv[8];
#pragma unroll
    for (int i = 0; i < 8; ++i) { const bf16_t* row = Z + (tokc + rg * 8 + i) * DIN + hh * 128 + 2 * cp;
        qv[i] = *(const unsigned*)(row + ZQB); fv[i] = *(const unsigned*)(row + ZFB); iv[i] = *(const unsigned*)(row + ZIB); }
    float cs[2][8], kk[2][8];
#pragma unroll
    for (int e = 0; e < 2; ++e) { float run = 0.f;
#pragma unroll
        for (int i = 0; i < 8; ++i) { const float fl = e ? bf_hi(fv[i]) : bf_lo(fv[i]); const float f = lbv[e] + (1.0f - lbv[e]) * sigmoidf_(fl);
            run += __builtin_amdgcn_logf(f); cs[e][i] = run; kk[e][i] = 1.0f - f; }
        PART[rg * 128 + 2 * cp + e] = run; }
    __syncthreads();
    {
        u32x4 itw[2];
#pragma unroll
        for (int e = 0; e < 2; ++e) {
            itw[e].x = e ? ((iv[0] >> 16) | (iv[1] & 0xffff0000u)) : ((iv[0] & 0xffffu) | (iv[1] << 16));
            itw[e].y = e ? ((iv[2] >> 16) | (iv[3] & 0xffff0000u)) : ((iv[2] & 0xffffu) | (iv[3] << 16));
            itw[e].z = e ? ((iv[4] >> 16) | (iv[5] & 0xffff0000u)) : ((iv[4] & 0xffffu) | (iv[5] << 16));
            itw[e].w = e ? ((iv[6] >> 16) | (iv[7] & 0xffff0000u)) : ((iv[6] & 0xffffu) | (iv[7] << 16));
            *(LAS u32x4*)(lds + HG_IT + (2 * cp + e) * TS + rg * 16) = itw[e];
        }
        float qd[2][8], qb[2][8], kd[2][8], kl[2][8];
#pragma unroll
        for (int e = 0; e < 2; ++e) { const int d = 2 * cp + e;
            float offs = 0.f, bmid = 0.f, blast = 0.f;
#pragma unroll
            for (int q = 0; q < 8; ++q) { const float p = PART[q * 128 + d]; offs += (q < rg) ? p : 0.f; bmid += (q < 4) ? p : 0.f; blast += p; }
            const float cM = fast_exp2(bmid), cL = fast_exp2(blast - bmid);
            if (rg == 0) DEC[d] = fast_exp2(blast);
#pragma unroll
            for (int i = 0; i < 8; ++i) { const float bb = offs + cs[e][i]; const float e1 = fast_exp2(bb - bmid), e2 = fast_exp2(bmid - bb);
                const float q = e ? bf_hi(qv[i]) : bf_lo(qv[i]); const float sq = q * sigmoidf_(q) * 0.08838834764831845f;
                qd[e][i] = sq * e1; qb[e][i] = qd[e][i] * cM; kd[e][i] = kk[e][i] * e2; kl[e][i] = kd[e][i] * cL; }
            u32x4 w; w.x = pk2(kl[e][0], kl[e][1]); w.y = pk2(kl[e][2], kl[e][3]); w.z = pk2(kl[e][4], kl[e][5]); w.w = pk2(kl[e][6], kl[e][7]);
            *(LAS u32x4*)(lds + HG_KLT + d * TS + rg * 16) = w;
        }
#pragma unroll
        for (int i = 0; i < 8; ++i) { const int t = rg * 8 + i;
            *(LAS unsigned*)(lds + HG_QD + t * RS + cp * 4) = pk2(qd[0][i], qd[1][i]);
            *(LAS unsigned*)(lds + HG_QB + t * RS + cp * 4) = pk2(qb[0][i], qb[1][i]);
            *(LAS unsigned*)(lds + HG_KD + t * RS + cp * 4) = pk2(kd[0][i], kd[1][i]); }
    }
    __syncthreads();
    if (wave < 4) {
        const int tq_ = (wave == 0 || wave == 3) ? 0 : 1, tp_ = (wave == 2 || wave == 3) ? 1 : 0;
        f32x16 a;
#pragma unroll
        for (int i = 0; i < 16; ++i) a[i] = 0.f;
        if (wave < 3) {
#pragma unroll
            for (int s = 0; s < 8; ++s) {
                const bf16x8 ka = *(const LAS bf16x8*)(lds + HG_KD + (32 * tp_ + r) * RS + (16 * s + 8 * h) * 2);
                const bf16x8 qb_ = *(const LAS bf16x8*)(lds + HG_QD + (32 * tq_ + r) * RS + (16 * s + 8 * h) * 2);
                a = MFMA32(ka, qb_, a);
            }
        }
        const int t = 32 * tq_ + r;
#pragma unroll
        for (int g = 0; g < 4; ++g) { float x[4];
#pragma unroll
            for (int j = 0; j < 4; ++j) { const int tp = 32 * tp_ + 8 * g + 4 * h + j; x[j] = (tp <= t) ? a[4 * g + j] : 0.f; }
            u32x2 w; w.x = pk2(x[0], x[1]); w.y = pk2(x[2], x[3]);
            *(LAS u32x2*)(lds + HG_AM + t * TS + (32 * tp_ + 8 * g + 4 * h) * 2) = w; }
    }
    __syncthreads();
    unsigned char* rec = REC + (size_t)item * RECB; unsigned char* itg = ITG + (size_t)item * 16384;
#pragma unroll
    for (int k = 0; k < 2; ++k) { const int j = tid + 512 * k; *(u32x4*)(rec + j * 16) = *(const LAS u32x4*)(lds + HG_QB + (j >> 4) * RS + (j & 15) * 16); }
#pragma unroll
    for (int k = 0; k < 2; ++k) { const int j = tid + 512 * k; *(u32x4*)(rec + 16384 + j * 16) = *(const LAS u32x4*)(lds + HG_KLT + (j >> 3) * TS + (j & 7) * 16); }
#pragma unroll
    for (int k = 0; k < 2; ++k) { const int j = tid + 512 * k; *(u32x4*)(itg + j * 16) = *(const LAS u32x4*)(lds + HG_IT + (j >> 3) * TS + (j & 7) * 16); }
    { const int j = tid; *(u32x4*)(rec + 32768 + j * 16) = *(const LAS u32x4*)(lds + HG_AM + (j >> 3) * TS + (j & 7) * 16); }
    if (tid < 32) *(u32x4*)(rec + 40960 + tid * 16) = *(const LAS u32x4*)(lds + HG_DEC + tid * 16);
}

__device__ __forceinline__ void hgrn_seq(LAS unsigned char* lds, const bf16_t* Z, bf16_t* YM, const unsigned char* REC, const unsigned char* ITG, const float* onorm, int bh, int tid) {
    const int b = bh >> 2, hh = bh & 3;
    const int wave = tid >> 6, lane = tid & 63, r = lane & 31, h = lane >> 5;
    const int vt = wave & 3, dh = wave >> 2;
    f32x16 S[2];
#pragma unroll
    for (int i = 0; i < 16; ++i) { S[0][i] = 0.f; S[1][i] = 0.f; }
    const int nt_ = tid >> 3, nseg = tid & 7;
    f32x4 og[4];
#pragma unroll
    for (int j = 0; j < 4; ++j) og[j] = *(const f32x4*)(onorm + nseg * 16 + 4 * j);
    LAS float* DEC = (LAS float*)(lds + HG_DEC);
    u32x4 pre[7], pdec = {0u, 0u, 0u, 0u}, g0, g1;
#define HG_LOAD(cc) do { const unsigned char* rec_ = REC + (size_t)(bh * 64 + (cc)) * RECB; const unsigned char* itg_ = ITG + (size_t)(bh * 64 + (cc)) * 16384; \
        pre[0] = *(const u32x4*)(rec_ + tid * 16); pre[1] = *(const u32x4*)(rec_ + (tid + 512) * 16); \
        pre[2] = *(const u32x4*)(rec_ + 16384 + tid * 16); pre[3] = *(const u32x4*)(rec_ + 16384 + (tid + 512) * 16); \
        pre[4] = *(const u32x4*)(itg_ + tid * 16); pre[5] = *(const u32x4*)(itg_ + (tid + 512) * 16); \
        pre[6] = *(const u32x4*)(rec_ + 32768 + tid * 16); if (tid < 32) pdec = *(const u32x4*)(rec_ + 40960 + tid * 16); } while (0)
#define HG_PUT() do { \
        *(LAS u32x4*)(lds + HG_QB + (tid >> 4) * RS + (tid & 15) * 16) = pre[0]; *(LAS u32x4*)(lds + HG_QB + ((tid + 512) >> 4) * RS + (tid & 15) * 16) = pre[1]; \
        *(LAS u32x4*)(lds + HG_KLT + (tid >> 3) * TS + (tid & 7) * 16) = pre[2]; *(LAS u32x4*)(lds + HG_KLT + ((tid + 512) >> 3) * TS + (tid & 7) * 16) = pre[3]; \
        *(LAS u32x4*)(lds + HG_IT + (tid >> 3) * TS + (tid & 7) * 16) = pre[4]; *(LAS u32x4*)(lds + HG_IT + ((tid + 512) >> 3) * TS + (tid & 7) * 16) = pre[5]; \
        *(LAS u32x4*)(lds + HG_AM + (tid >> 3) * TS + (tid & 7) * 16) = pre[6]; if (tid < 32) *(LAS u32x4*)(lds + HG_DEC + tid * 16) = pdec; } while (0)
    HG_LOAD(0); HG_PUT();
    __syncthreads();
    HG_LOAD(1);
    for (int c = 0; c < 64; ++c) {
        const size_t tokc = (size_t)b * T + (size_t)c * 64;
        { const bf16_t* grow = Z + (tokc + nt_) * DIN + ZGB + hh * 128 + nseg * 16; g0 = *(const u32x4*)grow; g1 = *(const u32x4*)(grow + 8); }
        {
            f32x16 o[2];
#pragma unroll
            for (int tt = 0; tt < 2; ++tt) {
#pragma unroll
                for (int i = 0; i < 16; ++i) o[tt][i] = 0.f;
#pragma unroll
                for (int s = 0; s < 2; ++s) {
                    const bf16x8 aa = *(const LAS bf16x8*)(lds + HG_AM + (32 * tt + r) * TS + (32 * dh + 16 * s + 8 * h) * 2);
                    const bf16x8 ib = *(const LAS bf16x8*)(lds + HG_IT + (32 * vt + r) * TS + (32 * dh + 16 * s + 8 * h) * 2);
                    o[tt] = MFMA32(aa, ib, o[tt]);
                }
            }
#pragma unroll
            for (int dt = 0; dt < 2; ++dt)
#pragma unroll
                for (int s = 0; s < 2; ++s) {
                    u32x4 sw; sw.x = pk2(S[dt][8 * s + 0], S[dt][8 * s + 1]); sw.y = pk2(S[dt][8 * s + 2], S[dt][8 * s + 3]); sw.z = pk2(S[dt][8 * s + 4], S[dt][8 * s + 5]); sw.w = pk2(S[dt][8 * s + 6], S[dt][8 * s + 7]);
                    const bf16x8 sb = __builtin_bit_cast(bf16x8, sw);
#pragma unroll
                    for (int tt = 0; tt < 2; ++tt) {
                        const LAS unsigned char* qp = lds + HG_QB + (32 * tt + r) * RS + (64 * dh + 32 * dt + 16 * s + 4 * h) * 2;
                        u32x4 aw; const u32x2 a0 = *(const LAS u32x2*)qp, a1 = *(const LAS u32x2*)(qp + 16); aw.x = a0.x; aw.y = a0.y; aw.z = a1.x; aw.w = a1.y;
                        o[tt] = MFMA32(__builtin_bit_cast(bf16x8, aw), sb, o[tt]);
                    }
                }
#pragma unroll
            for (int dt = 0; dt < 2; ++dt) {
#pragma unroll
                for (int i = 0; i < 16; ++i) S[dt][i] *= DEC[64 * dh + 32 * dt + (i & 3) + 8 * (i >> 2) + 4 * h];
#pragma unroll
                for (int s = 0; s < 4; ++s) {
                    const bf16x8 ka = *(const LAS bf16x8*)(lds + HG_KLT + (64 * dh + 32 * dt + r) * TS + (16 * s + 8 * h) * 2);
                    const bf16x8 ib = *(const LAS bf16x8*)(lds + HG_IT + (32 * vt + r) * TS + (16 * s + 8 * h) * 2);
                    S[dt] = MFMA32(ka, ib, S[dt]);
                }
            }
            LAS unsigned char* ob = lds + (dh ? HG_OB1 : HG_OB0);
#pragma unroll
            for (int tt = 0; tt < 2; ++tt)
#pragma unroll
                for (int i = 0; i < 16; ++i) *(LAS float*)(ob + (32 * tt + (i & 3) + 8 * (i >> 2) + 4 * h) * OS + (32 * vt + r) * 4) = o[tt][i];
        }
        __syncthreads();
        if (c < 63) { HG_PUT(); if (c < 62) HG_LOAD(c + 2); }
        {
            f32x4 ov[4]; float ss = 0.f;
#pragma unroll
            for (int j = 0; j < 4; ++j) { const f32x4 a = *(const LAS f32x4*)(lds + HG_OB0 + nt_ * OS + (nseg * 16 + 4 * j) * 4), bq = *(const LAS f32x4*)(lds + HG_OB1 + nt_ * OS + (nseg * 16 + 4 * j) * 4);
                ov[j] = a + bq; ss += (ov[j].x * ov[j].x + ov[j].y * ov[j].y) + (ov[j].z * ov[j].z + ov[j].w * ov[j].w); }
            ss += __shfl_xor(ss, 1); ss += __shfl_xor(ss, 2); ss += __shfl_xor(ss, 4);
            const float rstd = 1.0f / sqrtf(ss * (1.f / 128.f) + RMS_EPS);
            float gf[16];
#pragma unroll
            for (int j = 0; j < 4; ++j) { gf[2 * j] = bf_lo(g0[j]); gf[2 * j + 1] = bf_hi(g0[j]); gf[8 + 2 * j] = bf_lo(g1[j]); gf[8 + 2 * j + 1] = bf_hi(g1[j]); }
            float y[16];
#pragma unroll
            for (int j = 0; j < 4; ++j)
#pragma unroll
                for (int q = 0; q < 4; ++q) { const float g = gf[4 * j + q]; y[4 * j + q] = ov[j][q] * rstd * og[j][q] * (g * sigmoidf_(g)); }
            u32x4 w0, w1;
            w0.x = pk2(y[0], y[1]); w0.y = pk2(y[2], y[3]); w0.z = pk2(y[4], y[5]); w0.w = pk2(y[6], y[7]);
            w1.x = pk2(y[8], y[9]); w1.y = pk2(y[10], y[11]); w1.z = pk2(y[12], y[13]); w1.w = pk2(y[14], y[15]);
            bf16_t* orow = YM + (tokc + nt_) * D + 512 + hh * 128 + nseg * 16;
            *(u32x4*)orow = w0; *(u32x4*)(orow + 8) = w1;
        }
        __syncthreads();
    }
#undef HG_LOAD
#undef HG_PUT
}

constexpr int NPH = 12;
__global__ void __launch_bounds__(NTHREADS, 2) fwd_kernel(Args args) {
    extern __shared__ __attribute__((aligned(16))) unsigned char lds_raw[];
    LAS unsigned char* lds = (LAS unsigned char*)lds_raw;
    LAS unsigned char* xs = lds + XS_OFF;
    const int tid = threadIdx.x, lane = tid & 63, wave = __builtin_amdgcn_readfirstlane(tid >> 6);
    const int G = gridDim.x, bx = blockIdx.x;
    const int gw = bx * NWAVES + wave, NGW = G * NWAVES;
    unsigned char* ws = args.ws;
    bf16_t* WinT = (bf16_t*)(ws + WS_WIN); bf16_t* WoutT = (bf16_t*)(ws + WS_WOUT); bf16_t* WqB = (bf16_t*)(ws + WS_WQB); bf16_t* WkvT = (bf16_t*)(ws + WS_WKV);
    bf16_t* WoT = (bf16_t*)(ws + WS_WOT); bf16_t* WguT = (bf16_t*)(ws + WS_WGU); bf16_t* WdT = (bf16_t*)(ws + WS_WD);
    bf16_t* MN = (bf16_t*)(ws + WS_MN); bf16_t* KV = (bf16_t*)(ws + WS_KV); bf16_t* MC = (bf16_t*)(ws + WS_MC); bf16_t* VW = (bf16_t*)(ws + WS_VW);
    bf16_t* U = (bf16_t*)(ws + WS_U); bf16_t* P = (bf16_t*)(ws + WS_P); bf16_t* Z = (bf16_t*)(ws + WS_Z);
    float* Y12 = (float*)(ws + WS_Y12); float* Y3 = (float*)(ws + WS_Y3);
    const int lo = args.ph_lo, hi = args.ph_hi;
    cg::grid_group grid = cg::this_grid();
#ifndef PH_MASK
#define PH_MASK 0xfff
#endif
#define IN(k) (((PH_MASK >> (k)) & 1) && lo <= (k) && (k) < hi)
#define SEAM(k) do { if (IN(k) && IN((k) + 1)) grid.sync(); } while (0)

    if (IN(0)) {
        LAS float* scr = (LAS float*)(lds + wave * 16384);
        constexpr int I_IN = 16 * 88, I_SQ = 16 * 32, I_FF = 16 * 88, I_DN = 44 * 32;
        constexpr int NIT = I_IN + 4 * I_SQ + 2 * I_FF + I_DN;
        for (int it = gw; it < NIT; it += NGW) {
            int q = it;
            if (q < I_IN) { const int kb = q / 88, nb = q % 88; transpose_item(args.in[I_WIN], DIN, WinT, D, 64 * kb, 32 * nb, 32 * nb, 1.f, scr, lane); continue; } q -= I_IN;
            if (q < I_SQ) { const int kb = q / 32, nb = q % 32; transpose_item(args.in[I_WOUT], D, WoutT, D, 64 * kb, 32 * nb, 32 * nb, 1.f, scr, lane); continue; } q -= I_SQ;
            if (q < I_SQ) { const int kb = q / 32, nb = q % 32; transpose_item(args.in[I_WK], D, WkvT, D, 64 * kb, 32 * nb, 32 * nb, 1.f, scr, lane); continue; } q -= I_SQ;
            if (q < I_SQ) { const int kb = q / 32, nb = q % 32; transpose_item(args.in[I_WV], D, WkvT, D, 64 * kb, 32 * nb, 1024 + 32 * nb, 1.f, scr, lane); continue; } q -= I_SQ;
            if (q < I_SQ) { const int kb = q / 32, nb = q % 32; transpose_item(args.in[I_WO], D, WoT, D, 64 * kb, 32 * nb, 32 * nb, 1.f, scr, lane); continue; } q -= I_SQ;
            if (q < I_FF) { const int kb = q / 88, nb = q % 88, n0 = 32 * nb; transpose_item(args.in[I_WGATE], DFF, WguT, D, 64 * kb, n0, 256 * (n0 >> 7) + (n0 & 127), 1.f, scr, lane); continue; } q -= I_FF;
            if (q < I_FF) { const int kb = q / 88, nb = q % 88, n0 = 32 * nb; transpose_item(args.in[I_WUP], DFF, WguT, D, 64 * kb, n0, 256 * (n0 >> 7) + 128 + (n0 & 127), 1.f, scr, lane); continue; } q -= I_FF;
            { const int kb = q / 32, nb = q % 32; transpose_item(args.in[I_WDOWN], D, WdT, DFF, 64 * kb, 32 * nb, 32 * nb, 1.f, scr, lane); }
        }
        for (int i = gw * 64 + lane; i < D * D / 4; i += NGW * 64) { const f32x4 v = ((const f32x4*)args.in[I_WQ])[i]; u32x2 w; w.x = pk2(v.x * 0.0625f, v.y * 0.0625f); w.y = pk2(v.z * 0.0625f, v.w * 0.0625f); ((u32x2*)WqB)[i] = w; }
        for (int m = gw; m < MROWS; m += NGW) rms_row_to_bf16(args.in[I_MEM] + (size_t)m * D, args.in[I_GMEM], MN + (size_t)m * D, lane);
        for (int m = gw; m < M; m += NGW) rms_row_to_bf16(args.in[I_X] + (size_t)m * D, args.in[I_GMIXPRE], U + (size_t)m * D, lane);
    }
    SEAM(0);
    if (IN(1)) {
        pg8::ProbG1 g{U, WinT, MN, WkvT, D, D, D}; pg8::OrderG1 S{G, bx}; pg8::EpiBf16 E{Z, DIN, KV, 2048};
        pg8::gemm_phase(lds, xs, g, S, E);
    }
    SEAM(1);
    if (IN(2)) { for (int it = bx; it < 2048; it += G) hgrn_prep_item(lds, Z, args.in[I_LB], ws + WS_REC, ws + WS_IT, it, tid); }
    SEAM(2);
    if (IN(3)) {
        if (bx < 32 && G > 64) { hgrn_seq(lds, Z, P, ws + WS_REC, ws + WS_IT, args.in[I_ONORM], bx, tid); }
        else {
            const int nsw = (G > 64) ? G - 32 : G, c = (G > 64) ? bx - 32 : bx;
            if (G <= 64) { for (int bh = bx; bh < 32; bh += G) hgrn_seq(lds, Z, P, ws + WS_REC, ws + WS_IT, args.in[I_ONORM], bh, tid); }
            for (int it = c; it < 1024; it += nsw) swa_item(lds, Z, P, args.in[I_SINKS], it, tid);
        }
    }
    SEAM(3);
    if (IN(4)) {
#ifndef NO_MC
        { pg8::ProbMcat g{KV, WqB, args.k_small, 2048, 1024}; pg8::OrderLin S{32, 4, G, bx}; pg8::EpiBf16 E{MC, 1024, MC, 1024}; pg8::gemm_phase(lds, xs, g, S, E); }
#endif
#ifndef NO_VW
        { pg8::ProbVW g{WoT, KV, args.k_small, 1024, 2048}; pg8::OrderLin S{32, 4, G, (bx + G / 2) % G}; pg8::EpiBf16 E{VW, 1024, VW, 1024}; pg8::gemm_phase(lds, xs, g, S, E); }
#endif
#ifndef NO_G2
        pg8::ProbPlain g{P, WoutT, D, D, D}; pg8::OrderMN S{128, 4, G, bx}; pg8::EpiF32 E{Y12, D};
        pg8::gemm_phase(lds, xs, g, S, E);
#endif
    }
    SEAM(4);
    if (IN(5)) rownorm_pass(Y12, args.in[I_X], args.out, args.in[I_GMIXPOST], args.in[I_GXPRE], U, gw, NGW, lane);
    SEAM(5);
    if (IN(6)) {
        pg8::ProbBatchB g{U, MC, D, D, D}; pg8::OrderMN S{128, 4, G, bx}; pg8::EpiSoftmax E{P, D};
        pg8::gemm_phase(lds, xs, g, S, E);
    }
    SEAM(6);
    if (IN(7)) {
        pg8::ProbBatchB g{P, VW, D, D, D}; pg8::OrderMN S{128, 4, G, bx}; pg8::EpiF32 E{Y12, D};
        pg8::gemm_phase(lds, xs, g, S, E);
    }
    SEAM(7);
    if (IN(8)) rownorm_pass(Y12, args.out, args.out, args.in[I_GXPOST], args.in[I_GFFNPRE], U, gw, NGW, lane);
    SEAM(8);
    if (IN(9)) {
        pg8::ProbPlain g{U, WguT, D, D, D}; pg8::OrderMN S{128, 22, G, bx}; pg8::EpiSwiGLU E{Z, DFF};
        pg8::gemm_phase(lds, xs, g, S, E);
    }
    SEAM(9);
    if (IN(10)) {
        pg8::ProbPlain g{Z, WdT, DFF, DFF, DFF}; pg8::OrderMN S{128, 4, G, bx}; pg8::EpiF32 E{Y3, D};
        pg8::gemm_phase(lds, xs, g, S, E);
    }
    SEAM(10);
    if (IN(11)) rownorm_pass(Y3, args.out, args.out, args.in[I_GFFNPOST], nullptr, nullptr, gw, NGW, lane);
#undef IN
#undef SEAM
}

extern "C" void kernel_launch(void* const* d_in, const int* in_sizes, int n_in, void* d_out, int out_size, void* d_ws, size_t ws_size, hipStream_t stream) {
    static int grid = 0;
    if (grid == 0) {
        if (n_in != 21 || out_size != M * D || ws_size < WS_END) { fprintf(stderr, "kernel_launch: unexpected problem (n_in %d out %d ws %zu)\n", n_in, out_size, ws_size); grid = -1; return; }
        int dev = 0, cus = 0, per_cu = 0;
        hipGetDevice(&dev); hipDeviceGetAttribute(&cus, hipDeviceAttributeMultiprocessorCount, dev);
        if (hipFuncSetAttribute((const void*)fwd_kernel, hipFuncAttributeMaxDynamicSharedMemorySize, LDS_BYTES) != hipSuccess) { fprintf(stderr, "kernel_launch: hipFuncSetAttribute failed\n"); grid = -1; return; }
        hipOccupancyMaxActiveBlocksPerMultiprocessor(&per_cu, (const void*)fwd_kernel, NTHREADS, LDS_BYTES);
        (void)hipGetLastError();
        if (per_cu < 1) { fprintf(stderr, "kernel_launch: occupancy query says %d blocks per CU\n", per_cu); per_cu = 1; }
        grid = cus;
    }
    if (grid < 0) return;
    Args a{};
    for (int i = 0; i < 21; ++i) a.in[i] = (const float*)d_in[i];
    a.out = (float*)d_out; a.ws = (unsigned char*)d_ws; a.k_small = 256;
#if MK_PER_PHASE
    for (int p = 0; p < NPH; ++p) { a.ph_lo = p; a.ph_hi = p + 1; hipLaunchKernelGGL(fwd_kernel, dim3(grid), dim3(NTHREADS), LDS_BYTES, stream, a); }
#else
    a.ph_lo = 0; a.ph_hi = NPH;
    void* kargs[] = {&a};
    hipError_t e = hipLaunchCooperativeKernel((const void*)fwd_kernel, dim3(grid), dim3(NTHREADS), kargs, LDS_BYTES, stream);
    if (e != hipSuccess) fprintf(stderr, "cooperative launch failed: %s (grid %d)\n", hipGetErrorString(e), grid);
#endif
}
```
